# Optimizing an MI355X kernel written in HIP

```python
import math
import jax, jax.numpy as jnp
from jax import lax
import numpy as np

D_MODEL = 1024
BATCH = 16
SEQ = 256
DEPTH = 4
DEC_BATCH = 4
DEC_SEQ = 2048
PAST_LEN = 256

GRID_W = 64
MIX_WIDTH = D_MODEL
GROUP_W = MIX_WIDTH // 4
A_HEAD_DIM = 64
A_Q_HEADS = GROUP_W // A_HEAD_DIM
A_KV_HEADS = A_Q_HEADS // 2
B_HEADS = 4
B_V_DIM = GROUP_W // B_HEADS
B_QK_DIM = B_V_DIM // 2
POOL_WINDOWS = (2, 4, 8, 16)
C_GROUPS = len(POOL_WINDOWS)
C_GROUP_DIM = GROUP_W // C_GROUPS
CHUNK = 128
D_GROUPS = 4
D_GROUP_DIM = GROUP_W // D_GROUPS
D_FF = -(-8 * D_MODEL // (3 * 256)) * 256
N_MOD = 6
QBLOCK = 128
RMS_EPS = 1e-6
ROPE_THETA = 10000.0

IN_SIZES = [A_Q_HEADS * A_HEAD_DIM, A_KV_HEADS * A_HEAD_DIM, A_KV_HEADS * A_HEAD_DIM,
            B_HEADS * 2 * B_QK_DIM, B_HEADS * 2 * B_QK_DIM, B_HEADS * B_V_DIM,
            GROUP_W, 2 * GROUP_W]
IN_WIDTH = sum(IN_SIZES)
IN_SPLITS = [int(v) for v in np.cumsum(IN_SIZES)[:-1]]

kernel_name = "hybrid_diffusion_prefix_step"


def rms_norm(x, g):
    xf = x.astype(jnp.float32)
    y = xf * lax.rsqrt(jnp.mean(xf * xf, axis=-1, keepdims=True) + RMS_EPS)
    return (y * g.astype(jnp.float32)).astype(x.dtype)


def axial_rope(x):
    s, d = x.shape[1], x.shape[-1]
    rows = s // GRID_W
    row = jnp.repeat(jnp.arange(rows), GRID_W)
    col = jnp.tile(jnp.arange(GRID_W), rows)
    half = d // 2
    inv_freq = ROPE_THETA ** (-jnp.arange(0, half, 2, dtype=jnp.float32) / half)

    def rotate(xp, pos):
        ang = pos.astype(jnp.float32)[:, None] * inv_freq[None, :]
        ang = jnp.concatenate([ang, ang], axis=-1)[None, :, None, :]
        xf = xp.astype(jnp.float32)
        x1, x2 = jnp.split(xf, 2, axis=-1)
        return xf * jnp.cos(ang) + jnp.concatenate([-x2, x1], axis=-1) * jnp.sin(ang)

    out = jnp.concatenate([rotate(x[..., :half], row), rotate(x[..., half:], col)], axis=-1)
    return out.astype(x.dtype)


def gqa_attention(q, k, v):
    b, sq, hq, d = q.shape
    hkv = k.shape[2]
    g = hq // hkv
    nb = sq // QBLOCK
    scale = d ** -0.5
    qb = jnp.moveaxis(q.reshape(b, nb, QBLOCK, hkv, g, d), 1, 0)

    def block(qi):
        s = jnp.einsum("bqhgd,bkhd->bhgqk", qi, k, preferred_element_type=jnp.float32) * scale
        p = jax.nn.softmax(s, axis=-1)
        return jnp.einsum("bhgqk,bkhd->bqhgd", p.astype(v.dtype), v)

    o = jnp.moveaxis(lax.map(block, qb), 0, 1)
    return o.reshape(b, sq, hq * d)


def diff_attention(q, k, v, lam, lam_init, g_subln):
    b, sq, h, _, d = q.shape
    e = v.shape[-1]
    nb = sq // QBLOCK
    scale = d ** -0.5
    qb = jnp.moveaxis(q.reshape(b, nb, QBLOCK, h, 2, d), 1, 0)

    def block(qi):
        s = jnp.einsum("bqhjd,bkhjd->bhjqk", qi, k, preferred_element_type=jnp.float32) * scale
        p = jax.nn.softmax(s, axis=-1)
        w = p[:, :, 0] - lam * p[:, :, 1]
        return jnp.einsum("bhqk,bkhe->bqhe", w.astype(v.dtype), v)

    o = jnp.moveaxis(lax.map(block, qb), 0, 1).reshape(b, sq, h, e)
    o = rms_norm(o, g_subln) * (1.0 - lam_init)
    return o.reshape(b, sq, h * e)


def multiscale_pool(x, w_c, c_scale):
    b, s, _ = x.shape
    xg = x.reshape(b, s, C_GROUPS, C_GROUP_DIM)
    xf = xg.astype(jnp.float32)
    csum = jnp.concatenate([jnp.zeros((b, 1, C_GROUPS, C_GROUP_DIM), jnp.float32),
                            jnp.cumsum(xf, axis=1)], axis=1)
    t = jnp.arange(s)
    outs = []
    for gi, win in enumerate(POOL_WINDOWS):
        lo = jnp.clip(t - win // 2, 0, s)
        hi = jnp.clip(t + win // 2, 0, s)
        cs = csum[:, :, gi]
        mean = (cs[:, hi] - cs[:, lo]) / (hi - lo).astype(jnp.float32)[None, :, None]
        outs.append(mean - xf[:, :, gi])
    pooled = jnp.stack(outs, axis=2).astype(x.dtype)
    y = jnp.einsum("bsgc,gce->bsge", pooled, w_c).reshape(b, s, GROUP_W)
    return y * c_scale


def spatial_gating(z, g_v, w_s, b_s):
    b, s, _ = z.shape
    z = jax.nn.gelu(z)
    u, v = jnp.split(z, 2, axis=-1)
    v = rms_norm(v, g_v)
    vg = v.reshape(b, s // CHUNK, CHUNK, D_GROUPS, D_GROUP_DIM)
    sg = jnp.einsum("gpq,bnqgc->bnpgc", w_s, vg) + b_s.T[None, None, :, :, None]
    return u * sg.reshape(b, s, GROUP_W)


def modulation(cond, w_mod, b_mod):
    m = jax.nn.silu(cond) @ w_mod + b_mod
    return m.reshape(cond.shape[:-1] + (N_MOD, D_MODEL))


def mixer_block(h, p, lam_init, ctx):
    b, s, _ = h.shape
    proj = h @ p["w_in"]
    aq, ak, av, bq, bk, bv, cx, dz = jnp.split(proj, IN_SPLITS, axis=-1)
    aq = rms_norm(aq.reshape(b, s, A_Q_HEADS, A_HEAD_DIM), p["a_q_norm"])
    ak = rms_norm(ak.reshape(b, s, A_KV_HEADS, A_HEAD_DIM), p["a_k_norm"])
    av = av.reshape(b, s, A_KV_HEADS, A_HEAD_DIM)
    bq = bq.reshape(b, s, B_HEADS, 2, B_QK_DIM)
    bk = bk.reshape(b, s, B_HEADS, 2, B_QK_DIM)
    bv = bv.reshape(b, s, B_HEADS, B_V_DIM)
    own = (ak, av, bk, bv)
    if ctx is not None:
        aq = axial_rope(aq)
        ak = jnp.concatenate([ctx[0], axial_rope(ak)], axis=1)
        av = jnp.concatenate([ctx[1], av], axis=1)
        bq = axial_rope(bq.reshape(b, s, B_HEADS * 2, B_QK_DIM)).reshape(b, s, B_HEADS, 2, B_QK_DIM)
        bk_lat = axial_rope(bk.reshape(b, s, B_HEADS * 2, B_QK_DIM)).reshape(b, s, B_HEADS, 2, B_QK_DIM)
        bk = jnp.concatenate([ctx[2], bk_lat], axis=1)
        bv = jnp.concatenate([ctx[3], bv], axis=1)
    a_out = gqa_attention(aq, ak, av)
    f32 = jnp.float32
    lam = (jnp.exp(jnp.sum(p["b_lq1"].astype(f32) * p["b_lk1"].astype(f32)))
           - jnp.exp(jnp.sum(p["b_lq2"].astype(f32) * p["b_lk2"].astype(f32))) + lam_init)
    b_out = diff_attention(bq, bk, bv, lam, lam_init, p["b_subln"])
    c_out = multiscale_pool(cx, p["c_w"], p["c_scale"])
    d_out = spatial_gating(dz, p["d_v_norm"], p["d_ws"], p["d_bs"])
    y = jnp.concatenate([a_out.astype(h.dtype), b_out.astype(h.dtype),
                         c_out.astype(h.dtype), d_out.astype(h.dtype)], axis=-1) @ p["w_out"]
    return y, own


def trunk_layer(x, mod, p, lam_init, ctx):
    shift1, scale1, gate1, shift2, scale2, gate2 = [mod[:, i][:, None] for i in range(N_MOD)]
    h = rms_norm(x, p["g_pre_mix"]) * (1.0 + scale1) + shift1
    m, own = mixer_block(h, p, lam_init, ctx)
    x = x + gate1 * rms_norm(m, p["g_post_mix"])
    h = rms_norm(x, p["g_pre_ffn"]) * (1.0 + scale2) + shift2
    f = (jax.nn.silu(h @ p["w_gate"]) * (h @ p["w_up"])) @ p["w_down"]
    x = x + gate2 * rms_norm(f, p["g_post_ffn"])
    return x, own


def setup_inputs(seed: int = 0) -> dict:
    key = jax.random.key(seed)
    ks = jax.random.split(key, 32)
    f32 = jnp.float32

    def nrm(k, shape, s=1.0):
        return jax.random.normal(k, shape, f32) * s

    return {
        "x_prompt": nrm(ks[0], (BATCH, SEQ, D_MODEL)),
        "x_sample": nrm(ks[1], (DEC_BATCH, DEC_SEQ, D_MODEL)),
        "cache_a_k": nrm(ks[2], (DEC_BATCH, DEPTH, PAST_LEN, A_KV_HEADS, A_HEAD_DIM)),
        "cache_a_v": nrm(ks[3], (DEC_BATCH, DEPTH, PAST_LEN, A_KV_HEADS, A_HEAD_DIM)),
        "cache_b_k": nrm(ks[4], (DEC_BATCH, DEPTH, PAST_LEN, B_HEADS, 2, B_QK_DIM)),
        "cache_b_v": nrm(ks[5], (DEC_BATCH, DEPTH, PAST_LEN, B_HEADS, B_V_DIM)),
        "c": nrm(ks[6], (DEC_BATCH, D_MODEL)),
        "c_ctx": nrm(ks[7], (D_MODEL,)),
        "w_mod": nrm(ks[8], (DEPTH, D_MODEL, N_MOD * D_MODEL), 0.5 * D_MODEL ** -0.5),
        "b_mod": nrm(ks[9], (DEPTH, N_MOD * D_MODEL), 0.02),
        "g_pre_mix": 1.0 + nrm(ks[10], (DEPTH, D_MODEL), 0.05),
        "g_post_mix": 1.0 + nrm(ks[11], (DEPTH, D_MODEL), 0.05),
        "g_pre_ffn": 1.0 + nrm(ks[12], (DEPTH, D_MODEL), 0.05),
        "g_post_ffn": 1.0 + nrm(ks[13], (DEPTH, D_MODEL), 0.05),
        "w_in": nrm(ks[14], (DEPTH, D_MODEL, IN_WIDTH), D_MODEL ** -0.5),
        "w_out": nrm(ks[15], (DEPTH, MIX_WIDTH, D_MODEL), MIX_WIDTH ** -0.5),
        "a_q_norm": 1.0 + nrm(ks[16], (DEPTH, A_HEAD_DIM), 0.05),
        "a_k_norm": 1.0 + nrm(ks[17], (DEPTH, A_HEAD_DIM), 0.05),
        "b_lq1": nrm(ks[18], (DEPTH, B_QK_DIM), 0.1),
        "b_lk1": nrm(ks[19], (DEPTH, B_QK_DIM), 0.1),
        "b_lq2": nrm(ks[20], (DEPTH, B_QK_DIM), 0.1),
        "b_lk2": nrm(ks[21], (DEPTH, B_QK_DIM), 0.1),
        "b_subln": 1.0 + nrm(ks[22], (DEPTH, B_V_DIM), 0.05),
        "c_w": nrm(ks[23], (DEPTH, C_GROUPS, C_GROUP_DIM, C_GROUP_DIM), C_GROUP_DIM ** -0.5),
        "c_scale": 1.0 + nrm(ks[24], (DEPTH, GROUP_W), 0.1),
        "d_v_norm": 1.0 + nrm(ks[25], (DEPTH, GROUP_W), 0.05),
        "d_ws": nrm(ks[26], (DEPTH, D_GROUPS, CHUNK, CHUNK), CHUNK ** -0.5),
        "d_bs": 1.0 + nrm(ks[27], (DEPTH, D_GROUPS, CHUNK), 0.1),
        "w_gate": nrm(ks[28], (DEPTH, D_MODEL, D_FF), D_MODEL ** -0.5),
        "w_up": nrm(ks[29], (DEPTH, D_MODEL, D_FF), D_MODEL ** -0.5),
        "w_down": nrm(ks[30], (DEPTH, D_FF, D_MODEL), D_FF ** -0.5),
    }


def reference(x_prompt, x_sample, cache_a_k, cache_a_v, cache_b_k, cache_b_v, c, c_ctx,
              w_mod, b_mod, g_pre_mix, g_post_mix, g_pre_ffn, g_post_ffn, w_in, w_out,
              a_q_norm, a_k_norm, b_lq1, b_lk1, b_lq2, b_lk2, b_subln, c_w, c_scale,
              d_v_norm, d_ws, d_bs, w_gate, w_up, w_down):
    yp = x_prompt
    ys = x_sample
    new_ak, new_av, new_bk, new_bv = [], [], [], []
    for layer in range(DEPTH):
        p = {
            "w_in": w_in[layer], "w_out": w_out[layer],
            "g_pre_mix": g_pre_mix[layer], "g_post_mix": g_post_mix[layer],
            "g_pre_ffn": g_pre_ffn[layer], "g_post_ffn": g_post_ffn[layer],
            "a_q_norm": a_q_norm[layer], "a_k_norm": a_k_norm[layer],
            "b_lq1": b_lq1[layer], "b_lk1": b_lk1[layer],
            "b_lq2": b_lq2[layer], "b_lk2": b_lk2[layer], "b_subln": b_subln[layer],
            "c_w": c_w[layer], "c_scale": c_scale[layer],
            "d_v_norm": d_v_norm[layer], "d_ws": d_ws[layer], "d_bs": d_bs[layer],
            "w_gate": w_gate[layer], "w_up": w_up[layer], "w_down": w_down[layer],
        }
        lam_init = 0.8 - 0.6 * math.exp(-0.3 * layer)
        mod_ctx = modulation(c_ctx, w_mod[layer], b_mod[layer])[None]
        yp, own = trunk_layer(yp, mod_ctx, p, lam_init, None)
        new_ak.append(own[0])
        new_av.append(own[1])
        new_bk.append(own[2])
        new_bv.append(own[3])
        mod_lat = modulation(c, w_mod[layer], b_mod[layer])
        ctx = (cache_a_k[:, layer], cache_a_v[:, layer], cache_b_k[:, layer], cache_b_v[:, layer])
        ys, _ = trunk_layer(ys, mod_lat, p, lam_init, ctx)
    new_a_k = jnp.stack(new_ak, axis=1)
    new_a_v = jnp.stack(new_av, axis=1)
    new_b_k = jnp.stack(new_bk, axis=1)
    new_b_v = jnp.stack(new_bv, axis=1)
    return (yp, ys, new_a_k, new_a_v, new_b_k, new_b_v)
```

```cpp
#include <hip/hip_runtime.h>
#include <cstdio>
#include <cstdint>
namespace pg8 {
#define PG8_LAS __attribute__((address_space(3)))
typedef unsigned short bf16_t;
typedef short bf16x8 __attribute__((ext_vector_type(8)));
typedef float f32x4 __attribute__((ext_vector_type(4)));
typedef unsigned u32x4 __attribute__((ext_vector_type(4)));
constexpr int BM = 256, BK = 64, HALF = 128, HTB = HALF * BK * 2  , STAGE_BYTES = 8 * HTB, NXCD = 8, WGM = 8;

__host__ __device__ __forceinline__ int lds_byte(int r, int c) { const int st = (r >> 4) * 2 + (c >> 5), rr = r & 15, cc = c & 31, ob = rr * 64 + cc * 2; return st * 1024 + (ob ^ (((ob >> 9) & 1) << 5)); }
__host__ __device__ __forceinline__ void stage_rc(int b, int& R, int& C) { const int st = b / 1024, sb = b % 1024, swz = sb ^ (((sb >> 9) & 1) << 5); R = (st >> 1) * 16 + swz / 64; C = (st & 1) * 32 + (swz % 64) / 2; }
__host__ __device__ __forceinline__ int perm32(int rho) { const int n = rho >> 4, i = rho & 15; return 8 * (i >> 2) + 4 * n + (i & 3); }

struct Unit { int pm, pn; };
struct Gemm { const bf16_t* A; const bf16_t* Bt; int M, N, K; };

struct StaticOrder {
    int nM, nN, nwg, G, c;
    __host__ __device__ void init(int M, int N, int G_, int c_) { nM = M / BM; nN = N / BM; nwg = nM * nN; G = G_; c = c_; }
    __host__ __device__ bool next(int i, Unit& u) const {
        const long L = (long)i * G + c; if (L >= nwg) return false;
        int wgid = (int)L; { const int q = nwg / NXCD, r = nwg % NXCD, xcd = wgid % NXCD, off = wgid / NXCD; wgid = (xcd < r ? xcd * (q + 1) : r * (q + 1) + (xcd - r) * q) + off; }
        const int nig = WGM * nN, gid = wgid / nig, fm = gid * WGM, gsz = (nM - fm) < WGM ? (nM - fm) : WGM;
        u.pm = fm + ((wgid % nig) % gsz); u.pn = (wgid % nig) / gsz; return true;
    }
    __device__ __forceinline__ void a_ready(const Unit&) const {}
    __device__ __forceinline__ void done(const Unit&) const {}
};

__device__ __forceinline__ unsigned cvt_pk_bf16(float lo, float hi) { unsigned r; asm volatile("v_cvt_pk_bf16_f32 %0, %1, %2" : "=v"(r) : "v"(lo), "v"(hi)); return r; }
typedef float f32x2 __attribute__((ext_vector_type(2)));
template <class Epi, class Sched, bool ALIGN_EPI = false, bool SP2 = false>
__device__ __forceinline__ void gemm_phase(PG8_LAS unsigned char* lds, const Gemm g, const Sched& S, const Epi& E, const int tid_in) {
    const int tid = tid_in, wid = __builtin_amdgcn_readfirstlane(tid >> 6), lane = tid & 63, wr = wid >> 2, wc = wid & 3, fr = lane & 15, fq = lane >> 4;
    const int K = g.K, nt = K / BK;
    unsigned voffA[2], voffB[2];
#pragma unroll
    for (int i = 0; i < 2; ++i) { int R, C; stage_rc(tid * 16 + i * 8192, R, C); const int Rb = Epi::PERM ? ((R & ~31) + perm32(R & 31)) : R;
        voffA[i] = (unsigned)(R * K + C) * 2u; voffB[i] = (unsigned)(Rb * K + C) * 2u; }
    const size_t kstep = (size_t)(BK * 2);
    const size_t hstep = (size_t)HALF * K * 2;
    const size_t tstep = 2 * hstep;
    const unsigned ldsw = (unsigned)wid * 1024u;
    const int aoff = lds_byte(wr * 64 + fr, fq * 8), boff = lds_byte(wc * 32 + fr, fq * 8);
#define PG8_SA(b, h) (((b) * 2 + (h)) * HTB)
#define PG8_SB(b, h) ((4 + (b) * 2 + (h)) * HTB)
#define PG8_STAGE(bufoff, gbase, voff) do { _Pragma("unroll") for (int _i = 0; _i < 2; ++_i) \
        __builtin_amdgcn_global_load_lds((const unsigned*)((const char*)(gbase) + (voff)[_i]), (PG8_LAS unsigned*)(lds + (bufoff) + ldsw + _i * 8192), 16, 0, 0); } while (0)
#define PG8_LDA(dst, b, h) do { _Pragma("unroll") for (int m = 0; m < 4; ++m) _Pragma("unroll") for (int k = 0; k < 2; ++k) dst[m][k] = *(const PG8_LAS bf16x8*)(lds + PG8_SA(b, h) + aoff + m * 2048 + k * 1024); } while (0)
#define PG8_LDB(dst, b, h) do { _Pragma("unroll") for (int n = 0; n < 2; ++n) _Pragma("unroll") for (int k = 0; k < 2; ++k) dst[n][k] = *(const PG8_LAS bf16x8*)(lds + PG8_SB(b, h) + boff + n * 2048 + k * 1024); } while (0)
#define PG8_MMA(ai, bj, At, Bt) do { __builtin_amdgcn_s_setprio(1); _Pragma("unroll") for (int m = 0; m < 4; ++m) _Pragma("unroll") for (int n = 0; n < 2; ++n) _Pragma("unroll") for (int k = 0; k < 2; ++k) \
        acc[ai][bj][m][n] = __builtin_amdgcn_mfma_f32_16x16x32_bf16(Bt[n][k], At[m][k], acc[ai][bj][m][n], 0, 0, 0); __builtin_amdgcn_s_setprio(0); } while (0)
#define PG8_WAIT_V(n) asm volatile("s_waitcnt vmcnt(" #n ")" ::: "memory")
#define PG8_WAIT_L(n) asm volatile("s_waitcnt lgkmcnt(" #n ")" ::: "memory")
#define PG8_BAR __builtin_amdgcn_s_barrier()
#define PG8_SCHED __builtin_amdgcn_sched_barrier(0)
    Unit cur, nxt; int ui = 0;
    if (!S.next(0, cur)) return;
    f32x4 acc[2][2][4][2];
#pragma unroll
    for (int a = 0; a < 2; ++a)
#pragma unroll
        for (int b = 0; b < 2; ++b)
#pragma unroll
            for (int m = 0; m < 4; ++m)
#pragma unroll
                for (int n = 0; n < 2; ++n) acc[a][b][m][n] = (f32x4){0.f, 0.f, 0.f, 0.f};
    bf16x8 At[4][2], B0[2][2], B1[2][2];
    const char* cA = (const char*)g.A + (size_t)cur.pm * tstep; const char* cB = (const char*)g.Bt + (size_t)cur.pn * tstep;
    S.a_ready(cur);
    if constexpr (SP2) {
        PG8_STAGE(PG8_SB(0, 0), cB, voffB); PG8_STAGE(PG8_SB(0, 1), cB + hstep, voffB); PG8_STAGE(PG8_SA(0, 0), cA, voffA); PG8_STAGE(PG8_SA(0, 1), cA + hstep, voffA);
        if (wr == 1) PG8_BAR;
        PG8_WAIT_V(2); PG8_BAR;
        PG8_STAGE(PG8_SB(1, 0), cB + kstep, voffB); PG8_STAGE(PG8_SA(1, 0), cA + kstep, voffA); PG8_STAGE(PG8_SB(1, 1), cB + hstep + kstep, voffB);
        PG8_WAIT_V(6); PG8_BAR;
    } else {
        PG8_STAGE(PG8_SB(0, 0), cB, voffB); PG8_STAGE(PG8_SA(0, 0), cA, voffA); PG8_STAGE(PG8_SB(0, 1), cB + hstep, voffB); PG8_STAGE(PG8_SA(0, 1), cA + hstep, voffA);
        if (wr == 1) PG8_BAR;
        PG8_WAIT_V(4); PG8_BAR;
        PG8_STAGE(PG8_SB(1, 0), cB + kstep, voffB); PG8_STAGE(PG8_SA(1, 0), cA + kstep, voffA); PG8_STAGE(PG8_SB(1, 1), cB + hstep + kstep, voffB);
        PG8_WAIT_V(6); PG8_BAR;
    }
    for (;;) {
        const bool has_next = S.next(ui + 1, nxt);
        const char* nA = has_next ? (const char*)g.A + (size_t)nxt.pm * tstep : cA; const char* nB = has_next ? (const char*)g.Bt + (size_t)nxt.pn * tstep : cB;
        for (int t = 0; t < nt; t += 2) {
            const bool last = (t == nt - 2);
            const char* a1 = cA + (size_t)(t + 1) * kstep;
            const char* a2 = last ? nA : cA + (size_t)(t + 2) * kstep; const char* b2 = last ? nB : cB + (size_t)(t + 2) * kstep;
            const char* a3 = a2 + kstep; const char* b3 = b2 + kstep;
            if (last && has_next) S.a_ready(nxt);
            if constexpr (SP2) {
            PG8_LDB(B0, 0, 0); PG8_LDB(B1, 0, 1); PG8_SCHED; PG8_LDA(At, 0, 0); PG8_STAGE(PG8_SA(1, 1), a1 + hstep, voffA);
            PG8_WAIT_V(8); PG8_WAIT_L(0); PG8_BAR; PG8_MMA(0, 0, At, B0); PG8_MMA(0, 1, At, B1); PG8_BAR; PG8_SCHED;
            PG8_LDA(At, 0, 1); PG8_STAGE(PG8_SB(0, 0), b2, voffB); PG8_STAGE(PG8_SB(0, 1), b2 + hstep, voffB); PG8_STAGE(PG8_SA(0, 0), a2, voffA);
            PG8_WAIT_V(8); PG8_WAIT_L(0); PG8_BAR; PG8_MMA(1, 0, At, B0); PG8_MMA(1, 1, At, B1); PG8_BAR; PG8_SCHED;
            PG8_LDB(B0, 1, 0); PG8_LDB(B1, 1, 1); PG8_SCHED; PG8_LDA(At, 1, 0); PG8_STAGE(PG8_SA(0, 1), a2 + hstep, voffA);
            PG8_WAIT_V(8); PG8_WAIT_L(0); PG8_BAR; PG8_MMA(0, 0, At, B0); PG8_MMA(0, 1, At, B1); PG8_BAR; PG8_SCHED;
            PG8_LDA(At, 1, 1); PG8_STAGE(PG8_SB(1, 0), b3, voffB); PG8_STAGE(PG8_SB(1, 1), b3 + hstep, voffB); PG8_STAGE(PG8_SA(1, 0), a3, voffA);
            PG8_WAIT_V(8); PG8_WAIT_L(0); PG8_BAR; PG8_MMA(1, 0, At, B0); PG8_MMA(1, 1, At, B1); PG8_BAR; PG8_SCHED;
            } else {
            PG8_LDB(B0, 0, 0); PG8_SCHED; PG8_LDA(At, 0, 0); PG8_STAGE(PG8_SA(1, 1), a1 + hstep, voffA);
            PG8_WAIT_L(8); PG8_BAR; PG8_WAIT_L(0); PG8_MMA(0, 0, At, B0); PG8_BAR; PG8_SCHED;
            PG8_LDB(B1, 0, 1); PG8_STAGE(PG8_SB(0, 0), b2, voffB);
            PG8_BAR; PG8_WAIT_L(0); PG8_MMA(0, 1, At, B1); PG8_BAR;
            PG8_LDA(At, 0, 1); PG8_STAGE(PG8_SA(0, 0), a2, voffA);
            PG8_BAR; PG8_WAIT_L(0); PG8_MMA(1, 0, At, B0); PG8_BAR; PG8_SCHED;
            PG8_STAGE(PG8_SB(0, 1), b2 + hstep, voffB);
            PG8_WAIT_V(6); PG8_BAR; PG8_MMA(1, 1, At, B1); PG8_BAR;
            PG8_LDB(B0, 1, 0); PG8_SCHED; PG8_LDA(At, 1, 0); PG8_STAGE(PG8_SA(0, 1), a2 + hstep, voffA);
            PG8_WAIT_L(8); PG8_BAR; PG8_WAIT_L(0); PG8_MMA(0, 0, At, B0); PG8_BAR; PG8_SCHED;
            PG8_LDB(B1, 1, 1); PG8_STAGE(PG8_SB(1, 0), b3, voffB);
            PG8_BAR; PG8_WAIT_L(0); PG8_MMA(0, 1, At, B1); PG8_BAR;
            PG8_LDA(At, 1, 1); PG8_STAGE(PG8_SA(1, 0), a3, voffA);
            PG8_BAR; PG8_WAIT_L(0); PG8_MMA(1, 0, At, B0); PG8_BAR; PG8_SCHED;
            PG8_STAGE(PG8_SB(1, 1), b3 + hstep, voffB);
            PG8_WAIT_V(6); PG8_BAR; PG8_MMA(1, 1, At, B1); PG8_BAR;
            }
        }
        if constexpr (ALIGN_EPI) { if (wr == 0) PG8_BAR; }
        if constexpr (!Epi::AFTER_DRAIN) { E(acc, cur, wr, wc, fr, fq); S.done(cur); }
        if (!has_next) break;
#pragma unroll
        for (int a = 0; a < 2; ++a)
#pragma unroll
            for (int b = 0; b < 2; ++b)
#pragma unroll
                for (int m = 0; m < 4; ++m)
#pragma unroll
                    for (int n = 0; n < 2; ++n) acc[a][b][m][n] = (f32x4){0.f, 0.f, 0.f, 0.f};
        cur = nxt; cA = nA; cB = nB; ++ui;
        if constexpr (ALIGN_EPI) { if (wr == 1) PG8_BAR; }
    }
    PG8_WAIT_V(0);
    if constexpr (!ALIGN_EPI) { if (wr == 0) PG8_BAR; }
    PG8_BAR;
    if constexpr (Epi::AFTER_DRAIN) { E.fused(acc, cur, wr, wc, fr, fq, lds, wid, lane); S.done(cur); }
#undef PG8_SA
#undef PG8_SB
#undef PG8_STAGE
#undef PG8_LDA
#undef PG8_LDB
#undef PG8_MMA
#undef PG8_WAIT_V
#undef PG8_WAIT_L
#undef PG8_BAR
#undef PG8_SCHED
}
}
#define GAS __attribute__((address_space(1)))
#define LAS __attribute__((address_space(3)))
typedef unsigned short bf16;
typedef unsigned v4u __attribute__((ext_vector_type(4)));
typedef float f32x4 __attribute__((ext_vector_type(4)));
typedef short bf16x8 __attribute__((ext_vector_type(8)));
typedef GAS unsigned gu32;
typedef GAS unsigned long long gu64;
#define RLX_AGENT __ATOMIC_RELAXED, __HIP_MEMORY_SCOPE_AGENT
#define LDS_WAIT() asm volatile("s_waitcnt lgkmcnt(0)" ::: "memory")
#define VM_WAIT() asm volatile("s_waitcnt vmcnt(0)" ::: "memory")
__device__ __forceinline__ unsigned long long rt() { return __builtin_amdgcn_s_memrealtime(); }
__device__ __forceinline__ unsigned f2bf(float f) { unsigned u = __builtin_bit_cast(unsigned, f); return (u + 0x7fffu + ((u >> 16) & 1u)) >> 16; }
__device__ __forceinline__ unsigned pk2(float lo, float hi) { return f2bf(lo) | (f2bf(hi) << 16); }
#define XB_TMO      128
#define XB_XCNT(j)  (256  + 64 * (j))
#define XB_XSUB(j)  (1280 + 64 * (j))
#define XB_XGEN(j)  (2304 + 64 * (j))
#define XB_TOP      3328
#define XB_TOPGEN   3392
#define XCD_BAR_WORDS 3456
#define XB_SPIN_CAP (1u << 18)

__device__ __forceinline__ unsigned xb_ld(unsigned* p)              { return __hip_atomic_load(p, __ATOMIC_RELAXED, __HIP_MEMORY_SCOPE_AGENT); }
__device__ __forceinline__ unsigned xb_add(unsigned* p, unsigned v) { return __hip_atomic_fetch_add(p, v, __ATOMIC_RELAXED, __HIP_MEMORY_SCOPE_AGENT); }
__device__ __forceinline__ unsigned xb_xcc_id() { return (unsigned)__builtin_amdgcn_s_getreg((3 << 11) | 20) & 0xFu; }
#define XB_SPIN(cond, bar) do { unsigned _sp = 0; while (cond) { __builtin_amdgcn_s_sleep(1); \
    if ((++_sp & 255u) == 0u) { if (xb_ld(&(bar)[XB_TMO])) break; if (_sp > XB_SPIN_CAP) { atomicAdd(&(bar)[XB_TMO], 1u); break; } } } } while (0)

struct XcdBarrier {
    unsigned* bar; unsigned x;
    volatile LAS unsigned* st;
};

__device__ __forceinline__ XcdBarrier xcd_barrier_post(unsigned* bar, volatile LAS unsigned* st) {
    XcdBarrier b; b.bar = bar; b.x = xb_xcc_id(); b.st = st;
    if (threadIdx.x == 0) (void)xb_add(&bar[XB_XCNT(b.x)], 1u);
    return b;
}
__device__ __forceinline__ void xcd_barrier_complete(unsigned* bar, unsigned x, unsigned& nloc, unsigned& nx) {
    const unsigned G = gridDim.x * gridDim.y * gridDim.z;
    unsigned sum, cnt, mine, sp = 0u;
    for (;;) {
        sum = 0u; cnt = 0u; mine = 0u;
#pragma unroll
        for (unsigned j = 0; j < 16; ++j) { const unsigned c = xb_ld(&bar[XB_XCNT(j)]); sum += c; cnt += (c > 0u) ? 1u : 0u; mine = (j == x) ? c : mine; }
        if (sum == G) break;
        __builtin_amdgcn_s_sleep(1);
        if ((++sp & 255u) == 0u) { if (xb_ld(&bar[XB_TMO])) break; if (sp > XB_SPIN_CAP) { atomicAdd(&bar[XB_TMO], 1u); break; } }
    }
    nloc = mine > 0u ? mine : 1u; nx = cnt > 0u ? cnt : 1u;
}

__device__ __forceinline__ void xcd_barrier(const XcdBarrier& b) {
    asm volatile("s_waitcnt vmcnt(0)" ::: "memory");
    __syncthreads();
    if (threadIdx.x == 0) {
        unsigned* bar = b.bar;
        __builtin_amdgcn_s_waitcnt(0);
        unsigned nloc = b.st[0], nx = b.st[1];
        if (nloc == 0u) { xcd_barrier_complete(bar, b.x, nloc, nx); b.st[0] = nloc; b.st[1] = nx; }
        const unsigned old = xb_add(&bar[XB_XSUB(b.x)], 1u);
        const unsigned gen = old / nloc;
        if (old + 1u == (gen + 1u) * nloc) {
            __builtin_amdgcn_fence(__ATOMIC_RELEASE, "agent");
            asm volatile("s_waitcnt vmcnt(0)" ::: "memory");
            const unsigned og = xb_add(&bar[XB_TOP], 1u);
            const unsigned tg = og / nx;
            if (og + 1u == (tg + 1u) * nx) xb_add(&bar[XB_TOPGEN], 1u);
            else XB_SPIN(xb_ld(&bar[XB_TOPGEN]) == tg, bar);
            __builtin_amdgcn_fence(__ATOMIC_ACQUIRE, "agent");
            xb_add(&bar[XB_XGEN(b.x)], 1u);
            asm volatile("s_waitcnt vmcnt(0)" ::: "memory");
        } else {
            XB_SPIN(xb_ld(&bar[XB_XGEN(b.x)]) == gen, bar);
            __builtin_amdgcn_fence(__ATOMIC_ACQUIRE, "agent");
            asm volatile("s_waitcnt vmcnt(0)" ::: "memory");
        }
    }
    __syncthreads();
}

typedef float f32x16 __attribute__((ext_vector_type(16)));
typedef unsigned v2u __attribute__((ext_vector_type(2)));
typedef float f32x2v __attribute__((ext_vector_type(2)));
typedef short bf16x4 __attribute__((ext_vector_type(4)));

constexpr int NWAVES = 8, NTHR = 512;
constexpr int DM = 1024, NTOK = 12288, NCTX = 4096, DEPTH_L = 4, SEQC = 256, SEQL = 2048, PASTL = 256, SKL = 2304, DFF = 2816, NIN = 2048, NGU = 5632;
constexpr float EPS = 1e-6f;
constexpr float LOG2E = 1.4426950408889634f;
constexpr float QSCALE_A = 0.125f * LOG2E;
constexpr float QSCALE_B = 0.17677669529663687f * LOG2E;

constexpr size_t MiB = 1u << 20;
constexpr size_t WS_CTL = 0, CTL_ZERO_BYTES = 1 * MiB;
constexpr size_t WS_MOD = 1 * MiB;
constexpr size_t WS_WCT = WS_MOD + 512 * 1024;
constexpr size_t WS_WSB = WS_WCT + 128 * 1024;
constexpr size_t WS_ROPEA = WS_WSB + 512 * 1024;
constexpr size_t WS_ROPEB = WS_ROPEA + 8 * 1024;
constexpr size_t WS_LAM = WS_ROPEB + 4 * 1024;
constexpr size_t WS_PAR = 3 * MiB;
constexpr int P_GPREMIX = 0, P_GPOSTMIX = 4096, P_GPREFFN = 8192, P_GPOSTFFN = 12288, P_AQN = 16384, P_AKN = 16640, P_SUBLN = 16896, P_CSCALE = 17152, P_DVN = 18176, P_DBS = 19200, P_END = 21248;
constexpr size_t WS_WIN = 4 * MiB, WS_WOUT = 20 * MiB, WS_WGU = 28 * MiB, WS_WDN = 72 * MiB;
constexpr size_t WS_H = 94 * MiB, WS_QA = 118 * MiB, WS_QB = 124 * MiB, WS_KA = 130 * MiB, WS_VAT = 134 * MiB, WS_KB = 138 * MiB, WS_VBT = 146 * MiB;
constexpr size_t WS_CX = 154 * MiB, WS_U = 160 * MiB, WS_V = 166 * MiB, WS_MIX = 172 * MiB, WS_Y = 196 * MiB, WS_ACT = 244 * MiB;
constexpr size_t WS_KAC = 310 * MiB, WS_VATC = 311 * MiB, WS_KBC = 312 * MiB, WS_VBTC = 314 * MiB, WS_END = 316 * MiB;
constexpr size_t KA_LAT = (size_t)16 * 2 * 256 * 64, KB_LAT = (size_t)16 * 4 * 256 * 64;
constexpr size_t OUT_AK = 12582912, OUT_AV = 14680064, OUT_BK = 16777216, OUT_BV = 20971520, OUT_TOTAL = 25165824;
constexpr int CW_BAR = 4096;
constexpr int CW_QUEUE = 16384;

constexpr int RING_BYTES = 131072, LDSCTL_OFF = RING_BYTES, MISC_OFF = LDSCTL_OFF + 320, LDS_BYTES = 147456;

struct KArgs { const float* in[31]; float* out; unsigned char* ws; };

#define CAS __attribute__((address_space(4)))
struct Ctx {
    const CAS unsigned long long* kp;
    float* out; unsigned char* ws;
    LAS unsigned char* lds; int tid, lane, wave, G, bid;
};
#define WSP(T, off) ((T*)(C.ws + (off)))
#define INP(i) ((const float*)C.kp[i])
#define REFRESH_KP() asm volatile("" : "+s"(C.kp))

__device__ __forceinline__ float wave_sum(float v) {
#pragma unroll
    for (int o = 1; o < 64; o <<= 1) v += __shfl_xor(v, o);
    return v;
}
__device__ __forceinline__ unsigned pkbf(float lo, float hi) { return pg8::cvt_pk_bf16(lo, hi); }
__device__ __forceinline__ v2u pk4(f32x4 v) { v2u r; r.x = pkbf(v[0], v[1]); r.y = pkbf(v[2], v[3]); return r; }
__device__ __forceinline__ float bf2f(unsigned short b) { return __builtin_bit_cast(float, (unsigned)b << 16); }
__device__ __forceinline__ float gelu_tanh(float x) {
    const float y = 0.7978845608028654f * (x + 0.044715f * x * x * x);
    const float e = __expf(2.f * y);
    const float t = 1.f - 2.f / (e + 1.f);
    return 0.5f * x * (1.f + t);
}
__device__ __forceinline__ float silu_f(float x) { return x / (1.f + __expf(-x)); }
__device__ __forceinline__ int cond_of_row(int row) { return row < NCTX ? 0 : 1 + ((row - NCTX) >> 11); }

__device__ __forceinline__ f32x2v rope_cs(int pos, int f) {
    const int fl = f & 3, fh = f >> 2;
    const double b = fl == 0 ? 1.0 : fl == 1 ? 0.5623413251903491 : fl == 2 ? 0.31622776601683794 : 0.1778279410038923;
    const double p = fh == 0 ? 1.0 : fh == 1 ? 0.1 : fh == 2 ? 0.01 : 0.001;
    const double ang = (double)pos * b * p;
    const double twopi = 6.283185307179586476925287;
    const double r = ang - twopi * __builtin_rint(ang / twopi);
    const double r2 = r * r; double sn = r, cs = 1.0, ts = r, tc = 1.0;
#pragma unroll 1
    for (int n = 1; n <= 14; ++n) { tc *= -r2 / (double)((2 * n - 1) * (2 * n)); ts *= -r2 / (double)((2 * n) * (2 * n + 1)); cs += tc; sn += ts; }
    return (f32x2v){(float)cs, (float)sn};
}
template <int KIND> __device__ __forceinline__ int rowmap(int n) {
    if (KIND == 1) { const int pn = n >> 8, wc = (n >> 6) & 3, bj = (n >> 5) & 1, q = n & 31; return (pn << 8) + (bj << 7) + (wc << 5) + q; }
    if (KIND == 2) return ((n >> 7) << 8) + (n & 127);
    if (KIND == 3) return ((n >> 7) << 8) + 128 + (n & 127);
    return n;
}
template <int KIND> __device__ __forceinline__ void transpose_item(const float* W, int K, int N, bf16* WT, LAS float* scr, int item, int lane) {
    const int nblk = N / 32, kb = item / nblk, nb = item % nblk, k0 = 64 * kb, n0 = 32 * nb;
#pragma unroll 8
    for (int i = 0; i < 32; ++i) { const int kk = 2 * i + (lane >> 5); scr[kk * 33 + (lane & 31)] = W[(size_t)(k0 + kk) * N + n0 + (lane & 31)]; }
    LDS_WAIT(); asm volatile("" ::: "memory");
    const int c = lane & 7;
#pragma unroll
    for (int j = 0; j < 4; ++j) { const int n = (lane >> 3) + 8 * j; const LAS float* s = scr + (8 * c) * 33 + n;
        v4u o; o.x = pkbf(s[0 * 33], s[1 * 33]); o.y = pkbf(s[2 * 33], s[3 * 33]); o.z = pkbf(s[4 * 33], s[5 * 33]); o.w = pkbf(s[6 * 33], s[7 * 33]);
        *(v4u*)(WT + (size_t)rowmap<KIND>(n0 + n) * K + k0 + 8 * c) = o; }
    LDS_WAIT(); asm volatile("" ::: "memory");
}

__device__ __forceinline__ void prep_caches(const Ctx& Cin) {
    Ctx C = Cin; REFRESH_KP();
    const int gt = C.bid * NTHR + C.tid, NGT = C.G * NTHR;
    const float* cak = INP(2); const float* cav = INP(3); const float* cbk = INP(4); const float* cbv = INP(5);
    bf16* KA = WSP(bf16, WS_KAC); bf16* VAT = WSP(bf16, WS_VATC); bf16* KB = WSP(bf16, WS_KBC); bf16* VBT = WSP(bf16, WS_VBTC);
    for (int i = gt; i < 4 * 4 * 256 * 128; i += NGT) {
        const int d = i & 63, kvh = (i >> 6) & 1, key = (i >> 7) & 255, l = (i >> 15) & 3, b = i >> 17;
        const size_t hb = (size_t)(l * 4 + b) * 2 + kvh;
        KA[(hb * 256 + key) * 64 + d] = (bf16)f2bf(cak[i]);
        VAT[(hb * 64 + d) * 256 + key] = (bf16)f2bf(cav[i]);
    }
    for (int i = gt; i < 4 * 4 * 256 * 256; i += NGT) {
        const int d = i & 63, h = (i >> 6) & 3, key = (i >> 8) & 255, l = (i >> 16) & 3, b = i >> 18;
        const size_t hb = (size_t)(l * 4 + b) * 4 + h;
        KB[(hb * 256 + key) * 64 + d] = (bf16)f2bf(cbk[i]);
        VBT[(hb * 64 + d) * 256 + key] = (bf16)f2bf(cbv[i]);
    }
}

__device__ __forceinline__ void phase0(const Ctx& Cin) {
    Ctx C = Cin;
    {
        LAS float* scr = (LAS float*)(C.lds + C.wave * 16384);
        const int gw = C.bid * NWAVES + C.wave, NGW = C.G * NWAVES;
        constexpr int I_IN = 16 * 64, I_OUT = 16 * 32, I_G = 16 * 88, I_D = 44 * 32, I_L = I_IN + I_OUT + 2 * I_G + I_D;
        for (int it = gw; it < DEPTH_L * I_L; it += NGW) {
            const int l = it / I_L; int r = it % I_L; REFRESH_KP();
            if (r < I_IN) { transpose_item<1>(INP(14) + (size_t)l * DM * NIN, DM, NIN, WSP(bf16, WS_WIN) + (size_t)l * NIN * DM, scr, r, C.lane); continue; } r -= I_IN;
            if (r < I_OUT) { transpose_item<0>(INP(15) + (size_t)l * DM * DM, DM, DM, WSP(bf16, WS_WOUT) + (size_t)l * DM * DM, scr, r, C.lane); continue; } r -= I_OUT;
            if (r < I_G) { transpose_item<2>(INP(28) + (size_t)l * DM * DFF, DM, DFF, WSP(bf16, WS_WGU) + (size_t)l * NGU * DM, scr, r, C.lane); continue; } r -= I_G;
            if (r < I_G) { transpose_item<3>(INP(29) + (size_t)l * DM * DFF, DM, DFF, WSP(bf16, WS_WGU) + (size_t)l * NGU * DM, scr, r, C.lane); continue; } r -= I_G;
            transpose_item<0>(INP(30) + (size_t)l * DFF * DM, DFF, DM, WSP(bf16, WS_WDN) + (size_t)l * DM * DFF, scr, r, C.lane);
        }
    }
    __syncthreads();
    {
        REFRESH_KP();
        LAS float* sc = (LAS float*)C.lds;
        LAS float* red = (LAS float*)(C.lds + 20480);
        bool have = false;
        for (int task = C.bid; task < DEPTH_L * 96; task += C.G) {
            if (!have) {
                for (int i = C.tid; i < 5 * 1024; i += NTHR) { const int ci = i >> 10, k = i & 1023; const float v = ci == 0 ? INP(7)[k] : INP(6)[(ci - 1) * 1024 + k]; sc[i] = silu_f(v); }
                __syncthreads(); have = true;
            }
            const int l = task / 96, slab = task % 96, c4 = C.tid & 15, kg = C.tid >> 4;
            const float* W = INP(8) + (size_t)l * DM * 6144 + slab * 64 + c4 * 4;
            f32x4 acc[5];
#pragma unroll
            for (int ci = 0; ci < 5; ++ci) acc[ci] = (f32x4){0.f, 0.f, 0.f, 0.f};
#pragma unroll 4
            for (int kk = 0; kk < 32; ++kk) { const int k = kg * 32 + kk; const f32x4 w = *(const f32x4*)(W + (size_t)k * 6144);
#pragma unroll
                for (int ci = 0; ci < 5; ++ci) acc[ci] += w * sc[ci * 1024 + k]; }
#pragma unroll
            for (int ci = 0; ci < 5; ++ci) *(LAS f32x4*)(red + (kg * 5 + ci) * 64 + c4 * 4) = acc[ci];
            __syncthreads();
            if (C.tid < 320) { const int ci = C.tid >> 6, n = C.tid & 63; float s = 0.f;
#pragma unroll 8
                for (int g = 0; g < 32; ++g) s += red[(g * 5 + ci) * 64 + n];
                WSP(float, WS_MOD)[((size_t)l * 5 + ci) * 6144 + slab * 64 + n] = s + INP(9)[(size_t)l * 6144 + slab * 64 + n]; }
            __syncthreads();
        }
    }
    {
        REFRESH_KP();
        const int gt = C.bid * NTHR + C.tid, NGT = C.G * NTHR;
        for (int i = gt; i < 4 * 4 * 64 * 64; i += NGT) { const int c = i & 63, e = (i >> 6) & 63, lg = i >> 12; WSP(bf16, WS_WCT)[i] = (bf16)f2bf(INP(23)[((size_t)lg * 64 + c) * 64 + e]); }
        for (int i = gt; i < 4 * 4 * 128 * 128; i += NGT) WSP(bf16, WS_WSB)[i] = (bf16)f2bf(INP(26)[i]);
        for (int i = gt; i < 64 * 16; i += NGT) { const int pos = i >> 4, f = i & 15; WSP(f32x2v, WS_ROPEA)[i] = rope_cs(pos, f); }
        for (int i = gt; i < 64 * 8; i += NGT) { const int pos = i >> 3, f = i & 7; WSP(f32x2v, WS_ROPEB)[i] = rope_cs(pos, 2 * f); }
        if (gt < 4) { const int l = gt; float s1 = 0.f, s2 = 0.f;
            for (int i = 0; i < 32; ++i) { s1 += INP(18)[l * 32 + i] * INP(19)[l * 32 + i]; s2 += INP(20)[l * 32 + i] * INP(21)[l * 32 + i]; }
            const float lam_init = 0.8f - 0.6f * expf(-0.3f * (float)l);
            WSP(float, WS_LAM)[l] = expf(s1) - expf(s2) + lam_init; }
    }
    {
        REFRESH_KP();
        const int gt = C.bid * NTHR + C.tid, NGT = C.G * NTHR; float* P = WSP(float, WS_PAR);
        for (int i = gt; i < 4096; i += NGT) { P[P_GPREMIX + i] = INP(10)[i]; P[P_GPOSTMIX + i] = INP(11)[i]; P[P_GPREFFN + i] = INP(12)[i]; P[P_GPOSTFFN + i] = INP(13)[i]; }
        for (int i = gt; i < 256; i += NGT) { P[P_AQN + i] = INP(16)[i]; P[P_AKN + i] = INP(17)[i]; P[P_SUBLN + i] = INP(22)[i]; }
        for (int i = gt; i < 1024; i += NGT) { P[P_CSCALE + i] = INP(24)[i]; P[P_DVN + i] = INP(25)[i]; }
        for (int i = gt; i < 2048; i += NGT) P[P_DBS + i] = INP(27)[i];
    }
    prep_caches(C);
}

template <bool HAS_Y, bool FROM_IN>
__device__ __forceinline__ void rowwise(const Ctx& C, const bool HAS_H, const float* gate_mod  , const float* gpost, const float* gpre, const float* scale_mod, const float* shift_mod) {
    const int gw = C.bid * NWAVES + C.wave, NGW = C.G * NWAVES;
    const float* Y = WSP(float, WS_Y); bf16* H = WSP(bf16, WS_H);
    for (int row = gw; row < NTOK; row += NGW) {
        const int ci = cond_of_row(row);
        const float* xin = FROM_IN ? (row < NCTX ? INP(0) + (size_t)row * DM : INP(1) + (size_t)(row - NCTX) * DM) : C.out + (size_t)row * DM;
        f32x4 x[4];
#pragma unroll
        for (int j = 0; j < 4; ++j) x[j] = ((const f32x4*)xin)[C.lane + 64 * j];
        if (HAS_Y) {
            f32x4 y[4]; float s = 0.f;
#pragma unroll
            for (int j = 0; j < 4; ++j) { y[j] = ((const f32x4*)(Y + (size_t)row * DM))[C.lane + 64 * j]; s += (y[j][0] * y[j][0] + y[j][1] * y[j][1]) + (y[j][2] * y[j][2] + y[j][3] * y[j][3]); }
            const float r = rsqrtf(wave_sum(s) * (1.f / DM) + EPS);
#pragma unroll
            for (int j = 0; j < 4; ++j) { const f32x4 g = ((const f32x4*)(gate_mod + (size_t)ci * 6144))[C.lane + 64 * j]; const f32x4 gp = ((const f32x4*)gpost)[C.lane + 64 * j];
                x[j] = x[j] + g * (y[j] * r * gp); ((f32x4*)(C.out + (size_t)row * DM))[C.lane + 64 * j] = x[j]; }
        }
        if (FROM_IN && !HAS_Y) {
#pragma unroll
            for (int j = 0; j < 4; ++j) ((f32x4*)(C.out + (size_t)row * DM))[C.lane + 64 * j] = x[j];
        }
        if (HAS_H) {
            float s = 0.f;
#pragma unroll
            for (int j = 0; j < 4; ++j) s += (x[j][0] * x[j][0] + x[j][1] * x[j][1]) + (x[j][2] * x[j][2] + x[j][3] * x[j][3]);
            const float r = rsqrtf(wave_sum(s) * (1.f / DM) + EPS);
#pragma unroll
            for (int j = 0; j < 4; ++j) { const f32x4 gp = ((const f32x4*)gpre)[C.lane + 64 * j]; const f32x4 sc = ((const f32x4*)(scale_mod + (size_t)ci * 6144))[C.lane + 64 * j]; const f32x4 sh = ((const f32x4*)(shift_mod + (size_t)ci * 6144))[C.lane + 64 * j];
                const f32x4 h = (x[j] * r * gp) * (sc + 1.f) + sh; ((v2u*)(H + (size_t)row * DM))[C.lane + 64 * j] = pk4(h); }
        }
    }
}

struct EpiF32 {
    static constexpr bool PERM = false, AFTER_DRAIN = false;
    float* Y; int ldc;
    __device__ __forceinline__ void operator()(const f32x4 (&acc)[2][2][4][2], const pg8::Unit& u, int wr, int wc, int fr_in, int fq_in) const {
        int fr = fr_in, fq = fq_in; asm volatile("" : "+v"(fr), "+v"(fq));
#pragma unroll
        for (int ai = 0; ai < 2; ++ai)
#pragma unroll
            for (int m = 0; m < 4; ++m) { float* rowp = Y + (size_t)(u.pm * 256 + ai * 128 + wr * 64 + m * 16 + fr) * ldc + u.pn * 256 + wc * 32 + 4 * fq;
#pragma unroll
                for (int bj = 0; bj < 2; ++bj)
#pragma unroll
                    for (int n = 0; n < 2; ++n) *(f32x4*)(rowp + bj * 128 + n * 16) = acc[ai][bj][m][n]; }
    }
};
struct EpiGLU {
    static constexpr bool PERM = false, AFTER_DRAIN = false;
    bf16* O;
    __device__ __forceinline__ void operator()(const f32x4 (&acc)[2][2][4][2], const pg8::Unit& u, int wr, int wc, int fr_in, int fq_in) const {
        int fr = fr_in, fq = fq_in; asm volatile("" : "+v"(fr), "+v"(fq));
#pragma unroll
        for (int ai = 0; ai < 2; ++ai)
#pragma unroll
            for (int m = 0; m < 4; ++m) { bf16* rowp = O + (size_t)(u.pm * 256 + ai * 128 + wr * 64 + m * 16 + fr) * DFF + u.pn * 128 + wc * 32 + 4 * fq;
#pragma unroll
                for (int n = 0; n < 2; ++n) { const f32x4 g = acc[ai][0][m][n], up = acc[ai][1][m][n]; f32x4 o;
#pragma unroll
                    for (int e = 0; e < 4; ++e) o[e] = silu_f(g[e]) * up[e];
                    *(v2u*)(rowp + n * 16) = pk4(o); } }
    }
};
struct EpiProj {
    static constexpr bool PERM = false, AFTER_DRAIN = false;
    unsigned char* ws; float* out; int layer;
    __device__ __forceinline__ void operator()(const f32x4 (&acc)[2][2][4][2], const pg8::Unit& u, int wr, int wc, int fr_in, int fq_in) const {
        int fr = fr_in, fq = fq_in; asm volatile("" : "+v"(fr), "+v"(fq));
        const int pn = u.pn; const bool lat = u.pm >= 16;
        const f32x2v* ropeA = (const f32x2v*)(ws + WS_ROPEA); const f32x2v* ropeB = (const f32x2v*)(ws + WS_ROPEB);
#pragma unroll
        for (int ai = 0; ai < 2; ++ai)
#pragma unroll
            for (int m = 0; m < 4; ++m) {
                const int row = u.pm * 256 + ai * 128 + wr * 64 + m * 16 + fr;
                int b, s; if (lat) { const int rl = row - NCTX; b = rl >> 11; s = rl & 2047; } else { b = row >> 8; s = row & 255; }
                const int prow = s >> 6, pcol = s & 63;
                f32x4 v[2][2];
#pragma unroll
                for (int bj = 0; bj < 2; ++bj)
#pragma unroll
                    for (int n = 0; n < 2; ++n) v[bj][n] = acc[ai][bj][m][n];
                const int d0 = 4 * fq;
                if (pn == 0 || (pn == 1 && wc < 2)) {
                    float ss = 0.f;
#pragma unroll
                    for (int bj = 0; bj < 2; ++bj)
#pragma unroll
                        for (int n = 0; n < 2; ++n) ss += (v[bj][n][0] * v[bj][n][0] + v[bj][n][1] * v[bj][n][1]) + (v[bj][n][2] * v[bj][n][2] + v[bj][n][3] * v[bj][n][3]);
                    ss += __shfl_xor(ss, 16); ss += __shfl_xor(ss, 32);
                    const float r = rsqrtf(ss * (1.f / 64.f) + EPS);
                    const float* gn = (const float*)(ws + WS_PAR) + (pn == 0 ? P_AQN : P_AKN) + 64 * layer;
#pragma unroll
                    for (int bj = 0; bj < 2; ++bj)
#pragma unroll
                        for (int n = 0; n < 2; ++n) v[bj][n] = v[bj][n] * r * *(const f32x4*)(gn + 32 * bj + 16 * n + d0);
                    if (pn == 1 && !lat) {
                        float* o = out + OUT_AK + (((size_t)(b * 4 + layer) * 256 + s) * 128 + 64 * wc);
#pragma unroll
                        for (int bj = 0; bj < 2; ++bj)
#pragma unroll
                            for (int n = 0; n < 2; ++n) *(f32x4*)(o + 32 * bj + 16 * n + d0) = v[bj][n];
                    }
                    if (lat) {
#pragma unroll
                        for (int bj = 0; bj < 2; ++bj) { const int pos = bj == 0 ? prow : pcol;
#pragma unroll
                            for (int e = 0; e < 4; ++e) { const f32x2v cs = ropeA[pos * 16 + d0 + e]; const float x1 = v[bj][0][e], x2 = v[bj][1][e];
                                v[bj][0][e] = x1 * cs.x - x2 * cs.y; v[bj][1][e] = x2 * cs.x + x1 * cs.y; } }
                    }
                    if (pn == 0) {
                        bf16* o = (bf16*)(ws + WS_QA) + (size_t)row * 256 + 64 * wc;
#pragma unroll
                        for (int bj = 0; bj < 2; ++bj)
#pragma unroll
                            for (int n = 0; n < 2; ++n) *(v2u*)(o + 32 * bj + 16 * n + d0) = pk4(v[bj][n] * QSCALE_A);
                    } else {
                        bf16* o = (bf16*)(ws + WS_KA) + (lat ? KA_LAT + ((size_t)(b * 2 + wc) * SEQL + s) * 64 : ((size_t)(b * 2 + wc) * 256 + s) * 64);
#pragma unroll
                        for (int bj = 0; bj < 2; ++bj)
#pragma unroll
                            for (int n = 0; n < 2; ++n) *(v2u*)(o + 32 * bj + 16 * n + d0) = pk4(v[bj][n]);
                    }
                } else if (pn == 1) {
                    const int h = wc - 2;
                    if (!lat) { float* o = out + OUT_AV + (((size_t)(b * 4 + layer) * 256 + s) * 128 + 64 * h);
#pragma unroll
                        for (int bj = 0; bj < 2; ++bj)
#pragma unroll
                            for (int n = 0; n < 2; ++n) *(f32x4*)(o + 32 * bj + 16 * n + d0) = v[bj][n]; }
                    bf16* o = (bf16*)(ws + WS_VAT) + (lat ? KA_LAT + (size_t)(b * 2 + h) * 64 * SEQL + s : (size_t)(b * 2 + h) * 64 * 256 + s);
                    const int pitch = lat ? SEQL : 256;
#pragma unroll
                    for (int bj = 0; bj < 2; ++bj)
#pragma unroll
                        for (int n = 0; n < 2; ++n)
#pragma unroll
                            for (int e = 0; e < 4; ++e) o[(size_t)(32 * bj + 16 * n + d0 + e) * pitch] = (bf16)f2bf(v[bj][n][e]);
                } else if (pn == 2 || pn == 3) {
                    if (pn == 3 && !lat) { float* o = out + OUT_BK + (((size_t)(b * 4 + layer) * 256 + s) * 256 + 64 * wc);
#pragma unroll
                        for (int bj = 0; bj < 2; ++bj)
#pragma unroll
                            for (int n = 0; n < 2; ++n) *(f32x4*)(o + 32 * bj + 16 * n + d0) = v[bj][n]; }
                    if (lat) {
#pragma unroll
                        for (int bj = 0; bj < 2; ++bj)
#pragma unroll
                            for (int n = 0; n < 2; ++n) { const int pos = n == 0 ? prow : pcol;
#pragma unroll
                                for (int e = 0; e < 4; ++e) { const f32x2v cs = ropeB[pos * 8 + 4 * (fq & 1) + e]; const float mine = v[bj][n][e]; const float other = __shfl_xor(mine, 32);
                                    v[bj][n][e] = fq < 2 ? mine * cs.x - other * cs.y : mine * cs.x + other * cs.y; } }
                    }
                    if (pn == 2) { bf16* o = (bf16*)(ws + WS_QB) + (size_t)row * 256 + 64 * wc;
#pragma unroll
                        for (int bj = 0; bj < 2; ++bj)
#pragma unroll
                            for (int n = 0; n < 2; ++n) *(v2u*)(o + 32 * bj + 16 * n + d0) = pk4(v[bj][n] * QSCALE_B);
                    } else { bf16* o = (bf16*)(ws + WS_KB) + (lat ? KB_LAT + ((size_t)(b * 4 + wc) * SEQL + s) * 64 : ((size_t)(b * 4 + wc) * 256 + s) * 64);
#pragma unroll
                        for (int bj = 0; bj < 2; ++bj)
#pragma unroll
                            for (int n = 0; n < 2; ++n) *(v2u*)(o + 32 * bj + 16 * n + d0) = pk4(v[bj][n]); }
                } else if (pn == 4) {
                    if (!lat) { float* o = out + OUT_BV + (((size_t)(b * 4 + layer) * 256 + s) * 256 + 64 * wc);
#pragma unroll
                        for (int bj = 0; bj < 2; ++bj)
#pragma unroll
                            for (int n = 0; n < 2; ++n) *(f32x4*)(o + 32 * bj + 16 * n + d0) = v[bj][n]; }
                    bf16* o = (bf16*)(ws + WS_VBT) + (lat ? KB_LAT + (size_t)(b * 4 + wc) * 64 * SEQL + s : (size_t)(b * 4 + wc) * 64 * 256 + s);
                    const int pitch = lat ? SEQL : 256;
#pragma unroll
                    for (int bj = 0; bj < 2; ++bj)
#pragma unroll
                        for (int n = 0; n < 2; ++n)
#pragma unroll
                            for (int e = 0; e < 4; ++e) o[(size_t)(32 * bj + 16 * n + d0 + e) * pitch] = (bf16)f2bf(v[bj][n][e]);
                } else {
                    bf16* o = (bf16*)(ws + (pn == 5 ? WS_CX : pn == 6 ? WS_U : WS_V)) + (size_t)row * 256 + 64 * wc;
#pragma unroll
                    for (int bj = 0; bj < 2; ++bj)
#pragma unroll
                        for (int n = 0; n < 2; ++n) { f32x4 t = v[bj][n];
                            if (pn != 5) {
#pragma unroll
                                for (int e = 0; e < 4; ++e) t[e] = gelu_tanh(t[e]); }
                            *(v2u*)(o + 32 * bj + 16 * n + d0) = pk4(t); }
                }
            }
    }
};

constexpr int KS_STRIDE = 72, VS_STRIDE = 68, VS_OFF = 9216;
#define MFMA32(a, b, c) __builtin_amdgcn_mfma_f32_32x32x16_bf16(a, b, c, 0, 0, 0)
#define MFMA16(a, b, c) __builtin_amdgcn_mfma_f32_16x16x32_bf16(a, b, c, 0, 0, 0)

__device__ __forceinline__ bf16x8 pack8(const f32x16& p, int s) {
    v4u r; r.x = pkbf(p[8 * s + 0], p[8 * s + 1]); r.y = pkbf(p[8 * s + 2], p[8 * s + 3]); r.z = pkbf(p[8 * s + 4], p[8 * s + 5]); r.w = pkbf(p[8 * s + 6], p[8 * s + 7]);
    return __builtin_bit_cast(bf16x8, r);
}
__device__ __forceinline__ float max16(const f32x16& s) {
    float a = fmaxf(fmaxf(s[0], s[1]), fmaxf(s[2], s[3])), b = fmaxf(fmaxf(s[4], s[5]), fmaxf(s[6], s[7]));
    float c = fmaxf(fmaxf(s[8], s[9]), fmaxf(s[10], s[11])), d = fmaxf(fmaxf(s[12], s[13]), fmaxf(s[14], s[15]));
    return fmaxf(fmaxf(a, b), fmaxf(c, d));
}
__device__ __forceinline__ float softmax_step(f32x16& s, float& m_run, float& l_run) {
    float mx = max16(s); mx = fmaxf(mx, __shfl_xor(mx, 32));
    const float mn = fmaxf(m_run, mx); const float alpha = __builtin_amdgcn_exp2f(m_run - mn); m_run = mn;
    float sum = 0.f;
#pragma unroll
    for (int i = 0; i < 16; ++i) { s[i] = __builtin_amdgcn_exp2f(s[i] - mn); sum += s[i]; }
    l_run = l_run * alpha + sum;
    return alpha;
}

template <bool DIFF>
__device__ __forceinline__ void attn_unit(const Ctx& C, const bf16* Q  , const bf16* K0, const bf16* VT0, int pitch0, int nt0, const bf16* K1, const bf16* VT1, int pitch1, int nt1,
                                          bf16* O  , float lam, float post_scale, const float* subln) {
    LAS bf16* Ks = (LAS bf16*)C.lds; LAS bf16* Vs = (LAS bf16*)(C.lds + VS_OFF);
    const int r = C.lane & 31, hh = C.lane >> 5, w = C.wave;
    const bf16* qrow = Q + (size_t)(32 * w + r) * 256;
    bf16x8 qf[4];
#pragma unroll
    for (int kk = 0; kk < 4; ++kk) qf[kk] = *(const bf16x8*)(qrow + 16 * kk + 8 * hh);
    f32x16 O0[2], O1[2];
#pragma unroll
    for (int dt = 0; dt < 2; ++dt)
#pragma unroll
        for (int i = 0; i < 16; ++i) { O0[dt][i] = 0.f; O1[dt][i] = 0.f; }
    float m0 = -1e30f, l0 = 0.f, m1 = -1e30f, l1 = 0.f;
    const int nt = nt0 + nt1, srow = C.tid >> 3, sch = C.tid & 7;
    v4u kreg = *(const v4u*)(K0 + (size_t)srow * 64 + 8 * sch);
    v4u vreg = *(const v4u*)(VT0 + (size_t)srow * pitch0 + 8 * sch);
    for (int t = 0; t < nt; ++t) {
        __syncthreads();
        *(LAS v4u*)(Ks + srow * KS_STRIDE + 8 * sch) = kreg;
        *(LAS v2u*)(Vs + srow * VS_STRIDE + 8 * sch) = (v2u){vreg.x, vreg.y};
        *(LAS v2u*)(Vs + srow * VS_STRIDE + 8 * sch + 4) = (v2u){vreg.z, vreg.w};
        __syncthreads();
        if (t + 1 < nt) { const int tn = t + 1; const bool s0 = tn < nt0; const int tt = s0 ? tn : tn - nt0; const bf16* Kp = s0 ? K0 : K1; const bf16* Vp = s0 ? VT0 : VT1; const int pitch = s0 ? pitch0 : pitch1;
            kreg = *(const v4u*)(Kp + (size_t)(64 * tt + srow) * 64 + 8 * sch); vreg = *(const v4u*)(Vp + (size_t)srow * pitch + 64 * tt + 8 * sch); }
#pragma unroll 1
        for (int kt = 0; kt < 2; ++kt) {
            bf16x8 kf[4];
#pragma unroll
            for (int kk = 0; kk < 4; ++kk) kf[kk] = *(const LAS bf16x8*)(Ks + (32 * kt + r) * KS_STRIDE + 16 * kk + 8 * hh);
            f32x16 s0;
#pragma unroll
            for (int i = 0; i < 16; ++i) s0[i] = 0.f;
            if (!DIFF) {
#pragma unroll
                for (int kk = 0; kk < 4; ++kk) s0 = MFMA32(kf[kk], qf[kk], s0);
                const float a0 = softmax_step(s0, m0, l0);
                bf16x8 pf[2]; pf[0] = pack8(s0, 0); pf[1] = pack8(s0, 1);
#pragma unroll
                for (int dt = 0; dt < 2; ++dt) {
                    O0[dt] = O0[dt] * a0;
#pragma unroll
                    for (int s = 0; s < 2; ++s) {
                        const LAS bf16* vp = Vs + (32 * dt + r) * VS_STRIDE + 32 * kt + 16 * s + 4 * hh;
                        const v2u lo = *(const LAS v2u*)vp, hi = *(const LAS v2u*)(vp + 8);
                        const bf16x8 vf = __builtin_bit_cast(bf16x8, (v4u){lo.x, lo.y, hi.x, hi.y});
                        O0[dt] = MFMA32(vf, pf[s], O0[dt]);
                    }
                }
            } else {
                f32x16 s1;
#pragma unroll
                for (int i = 0; i < 16; ++i) s1[i] = 0.f;
#pragma unroll
                for (int kk = 0; kk < 2; ++kk) { s0 = MFMA32(kf[kk], qf[kk], s0); s1 = MFMA32(kf[2 + kk], qf[2 + kk], s1); }
                const float a0 = softmax_step(s0, m0, l0);
                const float a1 = softmax_step(s1, m1, l1);
                bf16x8 pf0[2], pf1[2]; pf0[0] = pack8(s0, 0); pf0[1] = pack8(s0, 1); pf1[0] = pack8(s1, 0); pf1[1] = pack8(s1, 1);
#pragma unroll
                for (int dt = 0; dt < 2; ++dt) {
                    O0[dt] = O0[dt] * a0; O1[dt] = O1[dt] * a1;
#pragma unroll
                    for (int s = 0; s < 2; ++s) {
                        const LAS bf16* vp = Vs + (32 * dt + r) * VS_STRIDE + 32 * kt + 16 * s + 4 * hh;
                        const v2u lo = *(const LAS v2u*)vp, hi = *(const LAS v2u*)(vp + 8);
                        const bf16x8 vf = __builtin_bit_cast(bf16x8, (v4u){lo.x, lo.y, hi.x, hi.y});
                        O0[dt] = MFMA32(vf, pf0[s], O0[dt]); O1[dt] = MFMA32(vf, pf1[s], O1[dt]);
                    }
                }
            }
        }
    }
    l0 += __shfl_xor(l0, 32); const float inv0 = 1.f / l0;
    bf16* orow = O + (size_t)(32 * w + r) * DM;
    if (!DIFF) {
#pragma unroll
        for (int dt = 0; dt < 2; ++dt)
#pragma unroll
            for (int g = 0; g < 4; ++g) { f32x4 o = {O0[dt][4 * g] * inv0, O0[dt][4 * g + 1] * inv0, O0[dt][4 * g + 2] * inv0, O0[dt][4 * g + 3] * inv0};
                *(v2u*)(orow + 32 * dt + 8 * g + 4 * hh) = pk4(o); }
    } else {
        l1 += __shfl_xor(l1, 32); const float inv1 = lam / l1;
        float ss = 0.f;
#pragma unroll
        for (int dt = 0; dt < 2; ++dt)
#pragma unroll
            for (int i = 0; i < 16; ++i) { const float o = O0[dt][i] * inv0 - O1[dt][i] * inv1; O0[dt][i] = o; ss += o * o; }
        ss += __shfl_xor(ss, 32);
        const float rr = rsqrtf(ss * (1.f / 64.f) + EPS) * post_scale;
#pragma unroll
        for (int dt = 0; dt < 2; ++dt)
#pragma unroll
            for (int g = 0; g < 4; ++g) { const f32x4 gn = *(const f32x4*)(subln + 32 * dt + 8 * g + 4 * hh);
                f32x4 o = {O0[dt][4 * g] * rr * gn[0], O0[dt][4 * g + 1] * rr * gn[1], O0[dt][4 * g + 2] * rr * gn[2], O0[dt][4 * g + 3] * rr * gn[3]};
                *(v2u*)(orow + 32 * dt + 8 * g + 4 * hh) = pk4(o); }
    }
}

__device__ __forceinline__ void pool_unit(const Ctx& C, int row0, int layer) {
    constexpr int XS = 264;
    LAS bf16* xs = (LAS bf16*)C.lds;
    LAS bf16* pl = (LAS bf16*)(C.lds + 80 * XS * 2);
    const bf16* CX = WSP(bf16, WS_CX);
    int S, bstart; if (row0 < NCTX) { S = SEQC; bstart = row0 & ~255; } else { S = SEQL; bstart = NCTX + ((row0 - NCTX) & ~2047); }
    const int t0 = row0 - bstart;
    __syncthreads();
    for (int i = C.tid; i < 80 * 32; i += NTHR) { const int rr = i >> 5, ch = i & 31; const int t = t0 - 8 + rr;
        v4u val = (v4u){0u, 0u, 0u, 0u}; if (t >= 0 && t < S) val = *(const v4u*)(CX + (size_t)(bstart + t) * 256 + 8 * ch);
        *(LAS v4u*)(xs + rr * XS + 8 * ch) = val; }
    __syncthreads();
    {
        const int cp = C.tid & 127, tq = C.tid >> 7, g = cp >> 5, half = 1 << g;
        for (int tt = 0; tt < 16; ++tt) { const int tl = tq * 16 + tt, t = t0 + tl;
            const int lo = max(t - half, 0), hi = min(t + half, S); float s0 = 0.f, s1 = 0.f;
            for (int k = lo; k < hi; ++k) { const unsigned pv = *(const LAS unsigned*)(xs + (k - t0 + 8) * XS + 2 * cp); s0 += bf2f((unsigned short)(pv & 0xffff)); s1 += bf2f((unsigned short)(pv >> 16)); }
            const unsigned cv = *(const LAS unsigned*)(xs + (tl + 8) * XS + 2 * cp); const float inv = 1.f / (float)(hi - lo);
            *(LAS unsigned*)(pl + tl * XS + 2 * cp) = pkbf(s0 * inv - bf2f((unsigned short)(cv & 0xffff)), s1 * inv - bf2f((unsigned short)(cv >> 16))); }
    }
    __syncthreads();
    {
        const int g = C.wave >> 1, mh = C.wave & 1, fr = C.lane & 15, fq = C.lane >> 4;
        const bf16* WCT = WSP(bf16, WS_WCT) + (size_t)(layer * 4 + g) * 4096;
        f32x4 acc[2][4];
#pragma unroll
        for (int mt = 0; mt < 2; ++mt)
#pragma unroll
            for (int nt = 0; nt < 4; ++nt) acc[mt][nt] = (f32x4){0.f, 0.f, 0.f, 0.f};
#pragma unroll
        for (int kk = 0; kk < 2; ++kk) {
            bf16x8 wf[4], xf[2];
#pragma unroll
            for (int nt = 0; nt < 4; ++nt) wf[nt] = *(const bf16x8*)(WCT + (16 * nt + fr) * 64 + 32 * kk + 8 * fq);
#pragma unroll
            for (int mt = 0; mt < 2; ++mt) xf[mt] = *(const LAS bf16x8*)(pl + (32 * mh + 16 * mt + fr) * XS + 64 * g + 32 * kk + 8 * fq);
#pragma unroll
            for (int mt = 0; mt < 2; ++mt)
#pragma unroll
                for (int nt = 0; nt < 4; ++nt) acc[mt][nt] = MFMA16(wf[nt], xf[mt], acc[mt][nt]);
        }
        const float* cs = WSP(float, WS_PAR) + P_CSCALE + layer * 256 + 64 * g;
        bf16* MIX = WSP(bf16, WS_MIX);
#pragma unroll
        for (int mt = 0; mt < 2; ++mt)
#pragma unroll
            for (int nt = 0; nt < 4; ++nt) { const f32x4 sc = *(const f32x4*)(cs + 16 * nt + 4 * fq);
                *(v2u*)(MIX + (size_t)(row0 + 32 * mh + 16 * mt + fr) * DM + 512 + 64 * g + 16 * nt + 4 * fq) = pk4(acc[mt][nt] * sc); }
    }
}

__device__ __forceinline__ void gate_unit(const Ctx& C, int row0, int layer) {
    constexpr int TS = 136;
    LAS bf16* vt = (LAS bf16*)C.lds;
    const bf16* V = WSP(bf16, WS_V); const bf16* U = WSP(bf16, WS_U);
    __syncthreads();
    {
        const int q = C.tid >> 2, qu = C.tid & 3;
        const bf16* src = V + (size_t)(row0 + q) * 256 + 64 * qu;
        v4u raw[8]; float ss = 0.f;
#pragma unroll
        for (int i = 0; i < 8; ++i) { raw[i] = *(const v4u*)(src + 8 * i);
#pragma unroll
            for (int j = 0; j < 4; ++j) { const float a = bf2f((unsigned short)(raw[i][j] & 0xffff)), b = bf2f((unsigned short)(raw[i][j] >> 16)); ss += a * a + b * b; } }
        ss += __shfl_xor(ss, 1); ss += __shfl_xor(ss, 2);
        const float r = rsqrtf(ss * (1.f / 256.f) + EPS);
        const float* gv = WSP(float, WS_PAR) + P_DVN + layer * 256 + 64 * qu;
#pragma unroll
        for (int i = 0; i < 8; ++i)
#pragma unroll
            for (int j = 0; j < 4; ++j) { const int c = 8 * i + 2 * j; const float a = bf2f((unsigned short)(raw[i][j] & 0xffff)) * r * gv[c], b = bf2f((unsigned short)(raw[i][j] >> 16)) * r * gv[c + 1];
                vt[(64 * qu + c) * TS + q] = (bf16)f2bf(a); vt[(64 * qu + c + 1) * TS + q] = (bf16)f2bf(b); }
    }
    __syncthreads();
    {
        const int g = C.wave >> 1, ph = C.wave & 1, fr = C.lane & 15, fq = C.lane >> 4;
        const bf16* WS_ = WSP(bf16, WS_WSB) + (size_t)(layer * 4 + g) * 16384;
        f32x4 acc[4][4];
#pragma unroll
        for (int pt = 0; pt < 4; ++pt)
#pragma unroll
            for (int ct = 0; ct < 4; ++ct) acc[pt][ct] = (f32x4){0.f, 0.f, 0.f, 0.f};
#pragma unroll
        for (int kk = 0; kk < 4; ++kk) {
            bf16x8 vf[4], wf[4];
#pragma unroll
            for (int ct = 0; ct < 4; ++ct) vf[ct] = *(const LAS bf16x8*)(vt + (64 * g + 16 * ct + fr) * TS + 32 * kk + 8 * fq);
#pragma unroll
            for (int pt = 0; pt < 4; ++pt) wf[pt] = *(const bf16x8*)(WS_ + (64 * ph + 16 * pt + fr) * 128 + 32 * kk + 8 * fq);
#pragma unroll
            for (int pt = 0; pt < 4; ++pt)
#pragma unroll
                for (int ct = 0; ct < 4; ++ct) acc[pt][ct] = MFMA16(vf[ct], wf[pt], acc[pt][ct]);
        }
        bf16* MIX = WSP(bf16, WS_MIX);
#pragma unroll
        for (int pt = 0; pt < 4; ++pt) { const int p = 64 * ph + 16 * pt + fr; const float bs = WSP(float, WS_PAR)[P_DBS + (layer * 4 + g) * 128 + p];
#pragma unroll
            for (int ct = 0; ct < 4; ++ct) { const v2u ur = *(const v2u*)(U + (size_t)(row0 + p) * 256 + 64 * g + 16 * ct + 4 * fq);
                f32x4 o; o[0] = bf2f((unsigned short)(ur.x & 0xffff)) * (acc[pt][ct][0] + bs); o[1] = bf2f((unsigned short)(ur.x >> 16)) * (acc[pt][ct][1] + bs);
                o[2] = bf2f((unsigned short)(ur.y & 0xffff)) * (acc[pt][ct][2] + bs); o[3] = bf2f((unsigned short)(ur.y >> 16)) * (acc[pt][ct][3] + bs);
                *(v2u*)(MIX + (size_t)(row0 + p) * DM + 768 + 64 * g + 16 * ct + 4 * fq) = pk4(o); } }
    }
}

constexpr int U_LATB = 128, U_LATA = 128, U_CTXB = 64, U_CTXA = 64, U_GATE = 96, U_POOL = 192, U_TOTAL = U_LATB + U_LATA + U_CTXB + U_CTXA + U_GATE + U_POOL;
__device__ __forceinline__ void mixer_phase(const Ctx& Cm, int layer) {
    volatile LAS unsigned* slot = (volatile LAS unsigned*)(Cm.lds + MISC_OFF + 64);
    gu32* head = (gu32*)(Cm.ws + WS_CTL) + CW_QUEUE + 64 * layer;
    const float lam = ((const float*)(Cm.ws + WS_LAM))[layer];
    const float lam_init = 0.8f - 0.6f * expf(-0.3f * (float)layer);
    for (;;) {
        __syncthreads();
        if (Cm.tid == 0) slot[0] = __hip_atomic_fetch_add(head, 1u, RLX_AGENT);
        __syncthreads();
        int u = (int)slot[0];
        if (u >= U_TOTAL) break;
        Ctx C = Cm; asm volatile("" : "+s"(C.ws));
        const float* subln = WSP(float, WS_PAR) + P_SUBLN + layer * 64;
        bf16* MIX = WSP(bf16, WS_MIX);
        if (u < U_LATB + U_LATA + U_CTXB + U_CTXA) {
            bool diff, lat; int b, h, row0;
            if (u < U_LATB) { diff = true; lat = true; b = u >> 5; h = (u >> 3) & 3; row0 = NCTX + b * SEQL + 256 * (u & 7); }
            else if (u < U_LATB + U_LATA) { const int v = u - U_LATB; diff = false; lat = true; b = v >> 5; h = (v >> 3) & 3; row0 = NCTX + b * SEQL + 256 * (v & 7); }
            else if (u < U_LATB + U_LATA + U_CTXB) { const int v = u - U_LATB - U_LATA; diff = true; lat = false; b = v >> 2; h = v & 3; row0 = 256 * b; }
            else { const int v = u - U_LATB - U_LATA - U_CTXB; diff = false; lat = false; b = v >> 2; h = v & 3; row0 = 256 * b; }
            if (diff) {
#ifndef SKIP_ATT_B
                const size_t hn = (size_t)b * 4 + h, hc = (size_t)(layer * 4 + b) * 4 + h;
                const bf16* K0 = lat ? WSP(bf16, WS_KBC) + hc * 256 * 64 : WSP(bf16, WS_KB) + hn * 256 * 64;
                const bf16* V0 = lat ? WSP(bf16, WS_VBTC) + hc * 64 * 256 : WSP(bf16, WS_VBT) + hn * 64 * 256;
                attn_unit<true>(C, WSP(bf16, WS_QB) + (size_t)row0 * 256 + 64 * h, K0, V0, 256, 4,
                                WSP(bf16, WS_KB) + KB_LAT + hn * SEQL * 64, WSP(bf16, WS_VBT) + KB_LAT + hn * 64 * SEQL, SEQL, lat ? 32 : 0,
                                MIX + (size_t)row0 * DM + 256 + 64 * h, lam, 1.f - lam_init, subln);
#endif
            } else {
#ifndef SKIP_ATT_A
                const int kvh = h >> 1; const size_t hn = (size_t)b * 2 + kvh, hc = (size_t)(layer * 4 + b) * 2 + kvh;
                const bf16* K0 = lat ? WSP(bf16, WS_KAC) + hc * 256 * 64 : WSP(bf16, WS_KA) + hn * 256 * 64;
                const bf16* V0 = lat ? WSP(bf16, WS_VATC) + hc * 64 * 256 : WSP(bf16, WS_VAT) + hn * 64 * 256;
                attn_unit<false>(C, WSP(bf16, WS_QA) + (size_t)row0 * 256 + 64 * h, K0, V0, 256, 4,
                                 WSP(bf16, WS_KA) + KA_LAT + hn * SEQL * 64, WSP(bf16, WS_VAT) + KA_LAT + hn * 64 * SEQL, SEQL, lat ? 32 : 0,
                                 MIX + (size_t)row0 * DM + 64 * h, 0.f, 1.f, subln);
#endif
            }
            continue;
        }
        u -= U_LATB + U_LATA + U_CTXB;
        u -= U_CTXA;
#ifndef SKIP_GATE
        if (u < U_GATE) { gate_unit(C, 128 * u, layer); continue; }
#endif
        u -= U_GATE;
#ifndef SKIP_POOL
        if (u >= 0) pool_unit(C, 64 * u, layer);
#endif
    }
}

__global__ void __launch_bounds__(NTHR, 2) fwd_kernel(KArgs args) {
    extern __shared__ __attribute__((aligned(16))) unsigned char lds_raw[];
    Ctx C;
    C.kp = (const CAS unsigned long long*)__builtin_amdgcn_kernarg_segment_ptr();
    C.out = args.out; C.ws = args.ws;
    C.lds = (LAS unsigned char*)lds_raw; C.tid = threadIdx.x; C.lane = C.tid & 63; C.wave = __builtin_amdgcn_readfirstlane(C.tid >> 6); C.G = gridDim.x; C.bid = blockIdx.x;
    for (int u = C.tid; u < (LDS_BYTES - LDSCTL_OFF) / 4; u += NTHR) ((LAS unsigned*)(C.lds + LDSCTL_OFF))[u] = 0u;
    __syncthreads();
    XcdBarrier bar = xcd_barrier_post((unsigned*)(C.ws + WS_CTL) + CW_BAR, (volatile LAS unsigned*)(C.lds + MISC_OFF) + 8);
#define GRID_BAR() xcd_barrier(bar)

    const Ctx C0 = C;
#define PHASE_CTX() Ctx C = C0; asm volatile("" : "+s"(C.ws), "+s"(C.out), "+v"(C.tid)); C.lane = C.tid & 63; C.wave = __builtin_amdgcn_readfirstlane(C.tid >> 6)
    constexpr int NSTEPS = 2 + 7 * DEPTH_L;
#pragma unroll 1
    for (int step = 0; step < NSTEPS; ++step) {
        const int l = step < 2 ? 0 : (step - 2) / 7, kind = step < 2 ? step : 2 + (step - 2) % 7;
        if (kind == 0) {
#ifndef SKIP_P0
            PHASE_CTX(); phase0(C);
#endif
        } else if (kind == 1) {
            PHASE_CTX(); const float* mod = WSP(float, WS_MOD);
            rowwise<false, true>(C, true, nullptr, nullptr, WSP(float, WS_PAR) + P_GPREMIX, mod + 1 * 1024, mod + 0 * 1024);
        } else if (kind == 2) {
            PHASE_CTX();
            pg8::Gemm g{WSP(bf16, WS_H), WSP(bf16, WS_WIN) + (size_t)l * NIN * DM, NTOK, NIN, DM}; pg8::StaticOrder S; S.init(NTOK, NIN, C.G, C.bid);
            EpiProj E{C.ws, C.out, l};
#ifndef SKIP_G1
            pg8::gemm_phase<EpiProj, pg8::StaticOrder, true, true>(C.lds, g, S, E, C.tid);
#endif
        } else if (kind == 3) {
#ifndef SKIP_MIX
            PHASE_CTX(); mixer_phase(C, l);
#endif
        } else if (kind == 4 || kind == 7) {
            PHASE_CTX();
            const bool dn = kind == 7;
            pg8::Gemm g{dn ? WSP(bf16, WS_ACT) : WSP(bf16, WS_MIX), dn ? WSP(bf16, WS_WDN) + (size_t)l * DM * DFF : WSP(bf16, WS_WOUT) + (size_t)l * DM * DM, NTOK, DM, dn ? DFF : DM};
            pg8::StaticOrder S; S.init(NTOK, DM, C.G, C.bid);
            EpiF32 E{WSP(float, WS_Y), DM};
#ifndef SKIP_G24
            pg8::gemm_phase<EpiF32, pg8::StaticOrder, true, true>(C.lds, g, S, E, C.tid);
#endif
        } else if (kind == 5 || kind == 8) {
            PHASE_CTX(); const float* mod = WSP(float, WS_MOD) + (size_t)l * 5 * 6144; const float* par = WSP(float, WS_PAR) + l * DM;
            if (kind == 5) rowwise<true, false>(C, true, mod + 2 * 1024, par + P_GPOSTMIX, par + P_GPREFFN, mod + 4 * 1024, mod + 3 * 1024);
            else           rowwise<true, false>(C, l + 1 < DEPTH_L, mod + 5 * 1024, par + P_GPOSTFFN, par + DM + P_GPREMIX, mod + 5 * 6144 + 1 * 1024, mod + 5 * 6144 + 0 * 1024);
        } else {
            PHASE_CTX();
            pg8::Gemm g{WSP(bf16, WS_H), WSP(bf16, WS_WGU) + (size_t)l * NGU * DM, NTOK, NGU, DM}; pg8::StaticOrder S; S.init(NTOK, NGU, C.G, C.bid);
            EpiGLU E{WSP(bf16, WS_ACT)};
#ifndef SKIP_G3
            pg8::gemm_phase<EpiGLU, pg8::StaticOrder, true, true>(C.lds, g, S, E, C.tid);
#endif
        }
        if (step + 1 < NSTEPS) GRID_BAR();
    }
}

extern "C" void kernel_launch(void* const* d_in, const int* in_sizes, int n_in, void* d_out, int out_size, void* d_ws, size_t ws_size, hipStream_t stream) {
    static int grid = 0;
    if (grid == 0) {
        if (n_in != 31 || (size_t)out_size != OUT_TOTAL || ws_size < WS_END) { fprintf(stderr, "kernel_launch: unexpected shapes: n_in %d out %d ws %zu (need %zu)\n", n_in, out_size, ws_size, (size_t)WS_END); grid = -1; return; }
        int dev = 0, cus = 0, per_cu = 0;
        if (hipGetDevice(&dev) != hipSuccess || hipDeviceGetAttribute(&cus, hipDeviceAttributeMultiprocessorCount, dev) != hipSuccess) { grid = -1; return; }
        if (hipFuncSetAttribute((const void*)fwd_kernel, hipFuncAttributeMaxDynamicSharedMemorySize, LDS_BYTES) != hipSuccess) { fprintf(stderr, "kernel_launch: hipFuncSetAttribute failed\n"); grid = -1; return; }
        if (hipOccupancyMaxActiveBlocksPerMultiprocessor(&per_cu, (const void*)fwd_kernel, NTHR, LDS_BYTES) != hipSuccess || per_cu < 1) { fprintf(stderr, "kernel_launch: occupancy query says %d blocks per CU\n", per_cu); (void)hipGetLastError(); grid = -1; return; }
        grid = cus;
    }
    if (grid < 0) return;
    if (hipMemsetAsync((char*)d_ws + WS_CTL, 0, CTL_ZERO_BYTES, stream) != hipSuccess) return;
    KArgs a{};
    for (int i = 0; i < 31; ++i) a.in[i] = (const float*)d_in[i];
    a.out = (float*)d_out; a.ws = (unsigned char*)d_ws;
    hipLaunchKernelGGL(fwd_kernel, dim3(grid), dim3(NTHR), LDS_BYTES, stream, a);
}
```

```cpp
#include <hip/hip_runtime.h>
#include <cstdio>
#include <cstdint>
namespace pg8 {
#define PG8_LAS __attribute__((address_space(3)))
typedef unsigned short bf16_t;
typedef short bf16x8 __attribute__((ext_vector_type(8)));
typedef float f32x4 __attribute__((ext_vector_type(4)));
typedef unsigned u32x4 __attribute__((ext_vector_type(4)));
constexpr int BM = 256, BK = 64, HALF = 128, HTB = HALF * BK * 2  , STAGE_BYTES = 8 * HTB, NXCD = 8, WGM = 8;

__host__ __device__ __forceinline__ int lds_byte(int r, int c) { const int st = (r >> 4) * 2 + (c >> 5), rr = r & 15, cc = c & 31, ob = rr * 64 + cc * 2; return st * 1024 + (ob ^ (((ob >> 9) & 1) << 5)); }
__host__ __device__ __forceinline__ void stage_rc(int b, int& R, int& C) { const int st = b / 1024, sb = b % 1024, swz = sb ^ (((sb >> 9) & 1) << 5); R = (st >> 1) * 16 + swz / 64; C = (st & 1) * 32 + (swz % 64) / 2; }
__host__ __device__ __forceinline__ int perm32(int rho) { const int n = rho >> 4, i = rho & 15; return 8 * (i >> 2) + 4 * n + (i & 3); }

struct Unit { int pm, pn; };
struct Gemm { const bf16_t* A; const bf16_t* Bt; int M, N, K; };

struct StaticOrder {
    int nM, nN, nwg, G, c;
    __host__ __device__ void init(int M, int N, int G_, int c_, int bm = BM) { nM = M / bm; nN = N / BM; nwg = nM * nN; G = G_; c = c_; }
    __host__ __device__ bool next(int i, Unit& u) const {
        const long L = (long)i * G + c; if (L >= nwg) return false;
        int wgid = (int)L; { const int q = nwg / NXCD, r = nwg % NXCD, xcd = wgid % NXCD, off = wgid / NXCD; wgid = (xcd < r ? xcd * (q + 1) : r * (q + 1) + (xcd - r) * q) + off; }
        const int nig = WGM * nN, gid = wgid / nig, fm = gid * WGM, gsz = (nM - fm) < WGM ? (nM - fm) : WGM;
        u.pm = fm + ((wgid % nig) % gsz); u.pn = (wgid % nig) / gsz; return true;
    }
    __device__ __forceinline__ void a_ready(const Unit&) const {}
    __device__ __forceinline__ void done(const Unit&) const {}
};

__device__ __forceinline__ unsigned cvt_pk_bf16(float lo, float hi) { unsigned r; asm volatile("v_cvt_pk_bf16_f32 %0, %1, %2" : "=v"(r) : "v"(lo), "v"(hi)); return r; }
typedef float f32x2 __attribute__((ext_vector_type(2)));
template <class Epi, class Sched, bool ALIGN_EPI = false, bool SP2 = false, int MT = 4  >
__device__ __forceinline__ void gemm_phase(PG8_LAS unsigned char* lds, const Gemm g, const Sched& S, const Epi& E, const int tid_in) {
    const int tid = tid_in, wid = __builtin_amdgcn_readfirstlane(tid >> 6), lane = tid & 63, wr = wid >> 2, wc = wid & 3, fr = lane & 15, fq = lane >> 4;
    const int K = g.K, nt = K / BK;
    unsigned voffA[2], voffB[2];
#pragma unroll
    for (int i = 0; i < 2; ++i) { int R, C; stage_rc(tid * 16 + i * 8192, R, C); const int Rb = Epi::PERM ? ((R & ~31) + perm32(R & 31)) : R;
        voffA[i] = (unsigned)(R * K + C) * 2u; voffB[i] = (unsigned)(Rb * K + C) * 2u; }
    const size_t kstep = (size_t)(BK * 2);
    const size_t hstepB = (size_t)HALF * K * 2, hstepA = (size_t)(32 * MT) * K * 2;
    const size_t tstepB = 2 * hstepB, tstepA = 2 * hstepA;
    const unsigned ldsw = (unsigned)wid * 1024u;
    const int aoff = lds_byte(wr * 16 * MT + fr, fq * 8), boff = lds_byte(wc * 32 + fr, fq * 8);
#define PG8_SA(b, h) (((b) * 2 + (h)) * HTB)
#define PG8_SB(b, h) ((4 + (b) * 2 + (h)) * HTB)
#define PG8_STAGE(bufoff, gbase, voff) do { _Pragma("unroll") for (int _i = 0; _i < 2; ++_i) \
        __builtin_amdgcn_global_load_lds((const unsigned*)((const char*)(gbase) + (voff)[_i]), (PG8_LAS unsigned*)(lds + (bufoff) + ldsw + _i * 8192), 16, 0, 0); } while (0)
#define PG8_LDA(dst, b, h) do { _Pragma("unroll") for (int m = 0; m < MT; ++m) _Pragma("unroll") for (int k = 0; k < 2; ++k) dst[m][k] = *(const PG8_LAS bf16x8*)(lds + PG8_SA(b, h) + aoff + m * 2048 + k * 1024); } while (0)
#define PG8_LDB(dst, b, h) do { _Pragma("unroll") for (int n = 0; n < 2; ++n) _Pragma("unroll") for (int k = 0; k < 2; ++k) dst[n][k] = *(const PG8_LAS bf16x8*)(lds + PG8_SB(b, h) + boff + n * 2048 + k * 1024); } while (0)
#define PG8_MMA(ai, bj, At, Bt) do { __builtin_amdgcn_s_setprio(1); _Pragma("unroll") for (int m = 0; m < MT; ++m) _Pragma("unroll") for (int n = 0; n < 2; ++n) _Pragma("unroll") for (int k = 0; k < 2; ++k) \
        acc[ai][bj][m][n] = __builtin_amdgcn_mfma_f32_16x16x32_bf16(Bt[n][k], At[m][k], acc[ai][bj][m][n], 0, 0, 0); __builtin_amdgcn_s_setprio(0); } while (0)
#define PG8_WAIT_V(n) asm volatile("s_waitcnt vmcnt(" #n ")" ::: "memory")
#define PG8_WAIT_L(n) asm volatile("s_waitcnt lgkmcnt(" #n ")" ::: "memory")
#define PG8_BAR __builtin_amdgcn_s_barrier()
#define PG8_SCHED __builtin_amdgcn_sched_barrier(0)
    Unit cur, nxt; int ui = 0;
    if (!S.next(0, cur)) return;
    f32x4 acc[2][2][MT][2];
#pragma unroll
    for (int a = 0; a < 2; ++a)
#pragma unroll
        for (int b = 0; b < 2; ++b)
#pragma unroll
            for (int m = 0; m < MT; ++m)
#pragma unroll
                for (int n = 0; n < 2; ++n) acc[a][b][m][n] = (f32x4){0.f, 0.f, 0.f, 0.f};
    bf16x8 At[MT][2], B0[2][2], B1[2][2];
    const char* cA = (const char*)g.A + (size_t)cur.pm * tstepA; const char* cB = (const char*)g.Bt + (size_t)cur.pn * tstepB;
    S.a_ready(cur);
    if constexpr (SP2) {
        PG8_STAGE(PG8_SB(0, 0), cB, voffB); PG8_STAGE(PG8_SB(0, 1), cB + hstepB, voffB); PG8_STAGE(PG8_SA(0, 0), cA, voffA); PG8_STAGE(PG8_SA(0, 1), cA + hstepA, voffA);
        if (wr == 1) PG8_BAR;
        PG8_WAIT_V(2); PG8_BAR;
        PG8_STAGE(PG8_SB(1, 0), cB + kstep, voffB); PG8_STAGE(PG8_SA(1, 0), cA + kstep, voffA); PG8_STAGE(PG8_SB(1, 1), cB + hstepB + kstep, voffB);
        PG8_WAIT_V(6); PG8_BAR;
    } else {
        PG8_STAGE(PG8_SB(0, 0), cB, voffB); PG8_STAGE(PG8_SA(0, 0), cA, voffA); PG8_STAGE(PG8_SB(0, 1), cB + hstepB, voffB); PG8_STAGE(PG8_SA(0, 1), cA + hstepA, voffA);
        if (wr == 1) PG8_BAR;
        PG8_WAIT_V(4); PG8_BAR;
        PG8_STAGE(PG8_SB(1, 0), cB + kstep, voffB); PG8_STAGE(PG8_SA(1, 0), cA + kstep, voffA); PG8_STAGE(PG8_SB(1, 1), cB + hstepB + kstep, voffB);
        PG8_WAIT_V(6); PG8_BAR;
    }
    for (;;) {
        const bool has_next = S.next(ui + 1, nxt);
        const char* nA = has_next ? (const char*)g.A + (size_t)nxt.pm * tstepA : cA; const char* nB = has_next ? (const char*)g.Bt + (size_t)nxt.pn * tstepB : cB;
        for (int t = 0; t < nt; t += 2) {
            const bool last = (t == nt - 2);
            const char* a1 = cA + (size_t)(t + 1) * kstep;
            const char* a2 = last ? nA : cA + (size_t)(t + 2) * kstep; const char* b2 = last ? nB : cB + (size_t)(t + 2) * kstep;
            const char* a3 = a2 + kstep; const char* b3 = b2 + kstep;
            if (last && has_next) S.a_ready(nxt);
            if constexpr (SP2) {
            PG8_LDB(B0, 0, 0); PG8_LDB(B1, 0, 1); PG8_SCHED; PG8_LDA(At, 0, 0); PG8_STAGE(PG8_SA(1, 1), a1 + hstepA, voffA);
            PG8_WAIT_V(8); PG8_WAIT_L(0); PG8_BAR; PG8_MMA(0, 0, At, B0); PG8_MMA(0, 1, At, B1); PG8_BAR; PG8_SCHED;
            PG8_LDA(At, 0, 1); PG8_STAGE(PG8_SB(0, 0), b2, voffB); PG8_STAGE(PG8_SB(0, 1), b2 + hstepB, voffB); PG8_STAGE(PG8_SA(0, 0), a2, voffA);
            PG8_WAIT_V(8); PG8_WAIT_L(0); PG8_BAR; PG8_MMA(1, 0, At, B0); PG8_MMA(1, 1, At, B1); PG8_BAR; PG8_SCHED;
            PG8_LDB(B0, 1, 0); PG8_LDB(B1, 1, 1); PG8_SCHED; PG8_LDA(At, 1, 0); PG8_STAGE(PG8_SA(0, 1), a2 + hstepA, voffA);
            PG8_WAIT_V(8); PG8_WAIT_L(0); PG8_BAR; PG8_MMA(0, 0, At, B0); PG8_MMA(0, 1, At, B1); PG8_BAR; PG8_SCHED;
            PG8_LDA(At, 1, 1); PG8_STAGE(PG8_SB(1, 0), b3, voffB); PG8_STAGE(PG8_SB(1, 1), b3 + hstepB, voffB); PG8_STAGE(PG8_SA(1, 0), a3, voffA);
            PG8_WAIT_V(8); PG8_WAIT_L(0); PG8_BAR; PG8_MMA(1, 0, At, B0); PG8_MMA(1, 1, At, B1); PG8_BAR; PG8_SCHED;
            } else {
            PG8_LDB(B0, 0, 0); PG8_SCHED; PG8_LDA(At, 0, 0); PG8_STAGE(PG8_SA(1, 1), a1 + hstepA, voffA);
            PG8_WAIT_L(8); PG8_BAR; PG8_WAIT_L(0); PG8_MMA(0, 0, At, B0); PG8_BAR; PG8_SCHED;
            PG8_LDB(B1, 0, 1); PG8_STAGE(PG8_SB(0, 0), b2, voffB);
            PG8_BAR; PG8_WAIT_L(0); PG8_MMA(0, 1, At, B1); PG8_BAR;
            PG8_LDA(At, 0, 1); PG8_STAGE(PG8_SA(0, 0), a2, voffA);
            PG8_BAR; PG8_WAIT_L(0); PG8_MMA(1, 0, At, B0); PG8_BAR; PG8_SCHED;
            PG8_STAGE(PG8_SB(0, 1), b2 + hstepB, voffB);
            PG8_WAIT_V(6); PG8_BAR; PG8_MMA(1, 1, At, B1); PG8_BAR;
            PG8_LDB(B0, 1, 0); PG8_SCHED; PG8_LDA(At, 1, 0); PG8_STAGE(PG8_SA(0, 1), a2 + hstepA, voffA);
            PG8_WAIT_L(8); PG8_BAR; PG8_WAIT_L(0); PG8_MMA(0, 0, At, B0); PG8_BAR; PG8_SCHED;
            PG8_LDB(B1, 1, 1); PG8_STAGE(PG8_SB(1, 0), b3, voffB);
            PG8_BAR; PG8_WAIT_L(0); PG8_MMA(0, 1, At, B1); PG8_BAR;
            PG8_LDA(At, 1, 1); PG8_STAGE(PG8_SA(1, 0), a3, voffA);
            PG8_BAR; PG8_WAIT_L(0); PG8_MMA(1, 0, At, B0); PG8_BAR; PG8_SCHED;
            PG8_STAGE(PG8_SB(1, 1), b3 + hstepB, voffB);
            PG8_WAIT_V(6); PG8_BAR; PG8_MMA(1, 1, At, B1); PG8_BAR;
            }
        }
        if constexpr (ALIGN_EPI) { if (wr == 0) PG8_BAR; }
        if constexpr (!Epi::AFTER_DRAIN) { E(acc, cur, wr, wc, fr, fq); S.done(cur); }
        if (!has_next) break;
#pragma unroll
        for (int a = 0; a < 2; ++a)
#pragma unroll
            for (int b = 0; b < 2; ++b)
#pragma unroll
                for (int m = 0; m < MT; ++m)
#pragma unroll
                    for (int n = 0; n < 2; ++n) acc[a][b][m][n] = (f32x4){0.f, 0.f, 0.f, 0.f};
        cur = nxt; cA = nA; cB = nB; ++ui;
        if constexpr (ALIGN_EPI) { if (wr == 1) PG8_BAR; }
    }
    PG8_WAIT_V(0);
    if constexpr (!ALIGN_EPI) { if (wr == 0) PG8_BAR; }
    PG8_BAR;
    if constexpr (Epi::AFTER_DRAIN) { E.fused(acc, cur, wr, wc, fr, fq, lds, wid, lane); S.done(cur); }
#undef PG8_SA
#undef PG8_SB
#undef PG8_STAGE
#undef PG8_LDA
#undef PG8_LDB
#undef PG8_MMA
#undef PG8_WAIT_V
#undef PG8_WAIT_L
#undef PG8_BAR
#undef PG8_SCHED
}
}
#define GAS __attribute__((address_space(1)))
#define LAS __attribute__((address_space(3)))
typedef unsigned short bf16;
typedef unsigned v4u __attribute__((ext_vector_type(4)));
typedef float f32x4 __attribute__((ext_vector_type(4)));
typedef short bf16x8 __attribute__((ext_vector_type(8)));
typedef GAS unsigned gu32;
typedef GAS unsigned long long gu64;
#define RLX_AGENT __ATOMIC_RELAXED, __HIP_MEMORY_SCOPE_AGENT
#define LDS_WAIT() asm volatile("s_waitcnt lgkmcnt(0)" ::: "memory")
#define VM_WAIT() asm volatile("s_waitcnt vmcnt(0)" ::: "memory")
__device__ __forceinline__ unsigned long long rt() { return __builtin_amdgcn_s_memrealtime(); }
__device__ __forceinline__ unsigned f2bf(float f) { unsigned u = __builtin_bit_cast(unsigned, f); return (u + 0x7fffu + ((u >> 16) & 1u)) >> 16; }
__device__ __forceinline__ unsigned pk2(float lo, float hi) { return f2bf(lo) | (f2bf(hi) << 16); }
#define XB_TMO      128
#define XB_XCNT(j)  (256  + 64 * (j))
#define XB_XSUB(j)  (1280 + 64 * (j))
#define XB_XGEN(j)  (2304 + 64 * (j))
#define XB_TOP      3328
#define XB_TOPGEN   3392
#define XCD_BAR_WORDS 3456
#define XB_SPIN_CAP (1u << 18)

__device__ __forceinline__ unsigned xb_ld(unsigned* p)              { return __hip_atomic_load(p, __ATOMIC_RELAXED, __HIP_MEMORY_SCOPE_AGENT); }
__device__ __forceinline__ unsigned xb_add(unsigned* p, unsigned v) { return __hip_atomic_fetch_add(p, v, __ATOMIC_RELAXED, __HIP_MEMORY_SCOPE_AGENT); }
__device__ __forceinline__ unsigned xb_xcc_id() { return (unsigned)__builtin_amdgcn_s_getreg((3 << 11) | 20) & 0xFu; }
#define XB_SPIN(cond, bar) do { unsigned _sp = 0; while (cond) { __builtin_amdgcn_s_sleep(1); \
    if ((++_sp & 255u) == 0u) { if (xb_ld(&(bar)[XB_TMO])) break; if (_sp > XB_SPIN_CAP) { atomicAdd(&(bar)[XB_TMO], 1u); break; } } } } while (0)

struct XcdBarrier {
    unsigned* bar; unsigned x;
    volatile LAS unsigned* st;
};

__device__ __forceinline__ XcdBarrier xcd_barrier_post(unsigned* bar, volatile LAS unsigned* st) {
    XcdBarrier b; b.bar = bar; b.x = xb_xcc_id(); b.st = st;
    if (threadIdx.x == 0) (void)xb_add(&bar[XB_XCNT(b.x)], 1u);
    return b;
}
__device__ __forceinline__ void xcd_barrier_complete(unsigned* bar, unsigned x, unsigned& nloc, unsigned& nx) {
    const unsigned G = gridDim.x * gridDim.y * gridDim.z;
    unsigned sum, cnt, mine, sp = 0u;
    for (;;) {
        sum = 0u; cnt = 0u; mine = 0u;
#pragma unroll
        for (unsigned j = 0; j < 16; ++j) { const unsigned c = xb_ld(&bar[XB_XCNT(j)]); sum += c; cnt += (c > 0u) ? 1u : 0u; mine = (j == x) ? c : mine; }
        if (sum == G) break;
        __builtin_amdgcn_s_sleep(1);
        if ((++sp & 255u) == 0u) { if (xb_ld(&bar[XB_TMO])) break; if (sp > XB_SPIN_CAP) { atomicAdd(&bar[XB_TMO], 1u); break; } }
    }
    nloc = mine > 0u ? mine : 1u; nx = cnt > 0u ? cnt : 1u;
}

__device__ __forceinline__ void xcd_barrier(const XcdBarrier& b) {
    asm volatile("s_waitcnt vmcnt(0)" ::: "memory");
    __syncthreads();
    if (threadIdx.x == 0) {
        unsigned* bar = b.bar;
        __builtin_amdgcn_s_waitcnt(0);
        unsigned nloc = b.st[0], nx = b.st[1];
        if (nloc == 0u) { xcd_barrier_complete(bar, b.x, nloc, nx); b.st[0] = nloc; b.st[1] = nx; }
        const unsigned old = xb_add(&bar[XB_XSUB(b.x)], 1u);
        const unsigned gen = old / nloc;
        if (old + 1u == (gen + 1u) * nloc) {
            __builtin_amdgcn_fence(__ATOMIC_RELEASE, "agent");
            asm volatile("s_waitcnt vmcnt(0)" ::: "memory");
            const unsigned og = xb_add(&bar[XB_TOP], 1u);
            const unsigned tg = og / nx;
            if (og + 1u == (tg + 1u) * nx) xb_add(&bar[XB_TOPGEN], 1u);
            else XB_SPIN(xb_ld(&bar[XB_TOPGEN]) == tg, bar);
            __builtin_amdgcn_fence(__ATOMIC_ACQUIRE, "agent");
            xb_add(&bar[XB_XGEN(b.x)], 1u);
            asm volatile("s_waitcnt vmcnt(0)" ::: "memory");
        } else {
            XB_SPIN(xb_ld(&bar[XB_XGEN(b.x)]) == gen, bar);
            __builtin_amdgcn_fence(__ATOMIC_ACQUIRE, "agent");
            asm volatile("s_waitcnt vmcnt(0)" ::: "memory");
        }
    }
    __syncthreads();
}

typedef float f32x16 __attribute__((ext_vector_type(16)));
typedef unsigned v2u __attribute__((ext_vector_type(2)));
typedef float f32x2v __attribute__((ext_vector_type(2)));
typedef short bf16x4 __attribute__((ext_vector_type(4)));

constexpr int NWAVES = 8, NTHR = 512;
constexpr int DM = 1024, NTOK = 12288, NCTX = 4096, DEPTH_L = 4, SEQC = 256, SEQL = 2048, PASTL = 256, SKL = 2304, DFF = 2816, NIN = 2048, NGU = 5632;
constexpr float EPS = 1e-6f;
constexpr float LOG2E = 1.4426950408889634f;
constexpr float QSCALE_A = 0.125f * LOG2E;
constexpr float QSCALE_B = 0.17677669529663687f * LOG2E;

constexpr size_t MiB = 1u << 20;
constexpr size_t WS_CTL = 0, CTL_ZERO_BYTES = 1 * MiB + 512 * 1024;
constexpr size_t WS_MOD = 1 * MiB;
constexpr size_t WS_WCT = WS_MOD + 512 * 1024;
constexpr size_t WS_WSB = WS_WCT + 128 * 1024;
constexpr size_t WS_ROPEA = WS_WSB + 512 * 1024;
constexpr size_t WS_ROPEB = WS_ROPEA + 8 * 1024;
constexpr size_t WS_LAM = WS_ROPEB + 4 * 1024;
constexpr size_t WS_PAR = 3 * MiB;
constexpr int P_GPREMIX = 0, P_GPOSTMIX = 4096, P_GPREFFN = 8192, P_GPOSTFFN = 12288, P_AQN = 16384, P_AKN = 16640, P_SUBLN = 16896, P_CSCALE = 17152, P_DVN = 18176, P_DBS = 19200, P_END = 21248;
constexpr size_t WS_WIN = 4 * MiB, WS_WOUT = 20 * MiB, WS_WGU = 28 * MiB, WS_WDN = 72 * MiB;
constexpr size_t WS_H = 94 * MiB, WS_QA = 118 * MiB, WS_QB = 124 * MiB, WS_KA = 130 * MiB, WS_VAT = 134 * MiB, WS_KB = 138 * MiB, WS_VBT = 146 * MiB;
constexpr size_t WS_CX = 154 * MiB, WS_U = 160 * MiB, WS_V = 166 * MiB, WS_MIX = 172 * MiB, WS_Y = 196 * MiB, WS_ACT = 244 * MiB;
constexpr size_t WS_KAC = 310 * MiB, WS_VATC = 311 * MiB, WS_KBC = 312 * MiB, WS_VBTC = 314 * MiB, WS_PARTIAL = 316 * MiB  , WS_END = 324 * MiB;
constexpr size_t KA_LAT = (size_t)16 * 2 * 256 * 64, KB_LAT = (size_t)16 * 4 * 256 * 64;
constexpr size_t OUT_AK = 12582912, OUT_AV = 14680064, OUT_BK = 16777216, OUT_BV = 20971520, OUT_TOTAL = 25165824;
constexpr int CW_BAR = 4096;
constexpr int CW_QUEUE = 16384;
constexpr int CW_MODCNT = 32768;

constexpr int RING_BYTES = 131072, LDSCTL_OFF = RING_BYTES, MISC_OFF = LDSCTL_OFF + 320, LDS_BYTES = 147456;

struct KArgs { const float* in[31]; float* out; unsigned char* ws; };

#define CAS __attribute__((address_space(4)))
struct Ctx {
    const CAS unsigned long long* kp;
    float* out; unsigned char* ws;
    LAS unsigned char* lds; int tid, lane, wave, G, bid;
};
#define WSP(T, off) ((T*)(C.ws + (off)))
#define INP(i) ((const float*)C.kp[i])
#define REFRESH_KP() asm volatile("" : "+s"(C.kp))

__device__ __forceinline__ float wave_sum(float v) {
#pragma unroll
    for (int o = 1; o < 64; o <<= 1) v += __shfl_xor(v, o);
    return v;
}
__device__ __forceinline__ unsigned pkbf(float lo, float hi) { return pg8::cvt_pk_bf16(lo, hi); }
__device__ __forceinline__ v2u pk4(f32x4 v) { v2u r; r.x = pkbf(v[0], v[1]); r.y = pkbf(v[2], v[3]); return r; }
__device__ __forceinline__ float bf2f(unsigned short b) { return __builtin_bit_cast(float, (unsigned)b << 16); }
__device__ __forceinline__ float gelu_tanh(float x) {
    const float y = 0.7978845608028654f * (x + 0.044715f * x * x * x);
    const float e = __expf(2.f * y);
    const float t = 1.f - 2.f / (e + 1.f);
    return 0.5f * x * (1.f + t);
}
__device__ __forceinline__ float silu_f(float x) { return x / (1.f + __expf(-x)); }
__device__ __forceinline__ int cond_of_row(int row) { return row < NCTX ? 0 : 1 + ((row - NCTX) >> 11); }

__device__ __forceinline__ f32x2v rope_cs(int pos, int f) {
    const float inv = __builtin_amdgcn_exp2f(-(float)f * 0.83048202372184059f);
    const float ang = (float)pos * inv;
    const float k = __builtin_rintf(ang * 0.15915494309189535f);
    float r = __builtin_fmaf(-k, 6.2831854820251465f, ang); r = __builtin_fmaf(-k, -1.7484555e-7f, r);
    const float r2 = r * r; float sn = r, cs = 1.f, ts = r, tc = 1.f;
#pragma unroll 1
    for (int n = 1; n <= 10; ++n) { tc *= -r2 / (float)((2 * n - 1) * (2 * n)); ts *= -r2 / (float)((2 * n) * (2 * n + 1)); cs += tc; sn += ts; }
    return (f32x2v){cs, sn};
}
template <int KIND> __device__ __forceinline__ int rowmap(int n) {
    if (KIND == 1) { const int pn = n >> 8, wc = (n >> 6) & 3, bj = (n >> 5) & 1, q = n & 31; return (pn << 8) + (bj << 7) + (wc << 5) + q; }
    if (KIND == 2) return ((n >> 7) << 8) + (n & 127);
    if (KIND == 3) return ((n >> 7) << 8) + 128 + (n & 127);
    return n;
}
template <int KIND> __device__ __forceinline__ void transpose_item(const float* W, int K, int N, bf16* WT, LAS unsigned char* scr, int item, int lane) {
    const int nblk = N / 64, kb = item / nblk, nb = item % nblk, k0 = 64 * kb, n0 = 64 * nb;
    const int rg = lane >> 4, c4 = lane & 15;
    const float* src = W + (size_t)(k0 + 16 * rg) * N + n0 + 4 * c4;
    f32x4 v[16];
#pragma unroll
    for (int i = 0; i < 16; ++i) v[i] = *(const f32x4*)(src + (size_t)i * N);
    LAS bf16* T = (LAS bf16*)scr;
#pragma unroll
    for (int e = 0; e < 4; ++e) {
        v4u lo, hi;
        lo.x = pkbf(v[0][e], v[1][e]); lo.y = pkbf(v[2][e], v[3][e]); lo.z = pkbf(v[4][e], v[5][e]); lo.w = pkbf(v[6][e], v[7][e]);
        hi.x = pkbf(v[8][e], v[9][e]); hi.y = pkbf(v[10][e], v[11][e]); hi.z = pkbf(v[12][e], v[13][e]); hi.w = pkbf(v[14][e], v[15][e]);
        *(LAS v4u*)(T + (4 * c4 + e) * 72 + 16 * rg) = lo; *(LAS v4u*)(T + (4 * c4 + e) * 72 + 16 * rg + 8) = hi;
    }
    LDS_WAIT(); asm volatile("" ::: "memory");
#pragma unroll
    for (int j = 0; j < 8; ++j) { const int n = (lane >> 3) + 8 * j, ch = lane & 7;
        const v4u o = *(const LAS v4u*)(T + n * 72 + 8 * ch);
        *(v4u*)(WT + (size_t)rowmap<KIND>(n0 + n) * K + k0 + 8 * ch) = o; }
    LDS_WAIT(); asm volatile("" ::: "memory");
}

__device__ __forceinline__ void prep_caches(const Ctx& Cin) {
    Ctx C = Cin; REFRESH_KP();
    const int gt = C.bid * NTHR + C.tid, NGT = C.G * NTHR;
    const float* cak = INP(2); const float* cav = INP(3); const float* cbk = INP(4); const float* cbv = INP(5);
    bf16* KA = WSP(bf16, WS_KAC); bf16* VAT = WSP(bf16, WS_VATC); bf16* KB = WSP(bf16, WS_KBC); bf16* VBT = WSP(bf16, WS_VBTC);
    for (int i = gt; i < 4 * 4 * 256 * 128; i += NGT) {
        const int d = i & 63, kvh = (i >> 6) & 1, key = (i >> 7) & 255, l = (i >> 15) & 3, b = i >> 17;
        const size_t hb = (size_t)(l * 4 + b) * 2 + kvh;
        KA[(hb * 256 + key) * 64 + d] = (bf16)f2bf(cak[i]);
        VAT[(hb * 64 + d) * 256 + key] = (bf16)f2bf(cav[i]);
    }
    for (int i = gt; i < 4 * 4 * 256 * 256; i += NGT) {
        const int d = i & 63, h = (i >> 6) & 3, key = (i >> 8) & 255, l = (i >> 16) & 3, b = i >> 18;
        const size_t hb = (size_t)(l * 4 + b) * 4 + h;
        KB[(hb * 256 + key) * 64 + d] = (bf16)f2bf(cbk[i]);
        VBT[(hb * 64 + d) * 256 + key] = (bf16)f2bf(cbv[i]);
    }
}

__device__ __forceinline__ void phase0(const Ctx& Cin) {
    Ctx C = Cin;
    {
        LAS unsigned char* scr = C.lds + C.wave * 16384;
        const int gw = C.bid * NWAVES + C.wave, NGW = C.G * NWAVES;
        constexpr int I_MOD = DEPTH_L * 24 * 16;
        constexpr int I_IN = 16 * 32, I_OUT = 16 * 16, I_G = 16 * 44, I_D = 44 * 16, I_L = I_IN + I_OUT + 2 * I_G + I_D;
        for (int it = gw; it < I_MOD + DEPTH_L * I_L; it += NGW) {
            REFRESH_KP();
            if (it < I_MOD) {
                const int kc = it & 15, slab = (it >> 4) % 24, l = it / (16 * 24);
                LAS float* sc = (LAS float*)scr;
#pragma unroll
                for (int ci = 0; ci < 5; ++ci) { const float cv = ci == 0 ? INP(7)[64 * kc + C.lane] : INP(6)[(ci - 1) * 1024 + 64 * kc + C.lane]; sc[ci * 64 + C.lane] = silu_f(cv); }
                LDS_WAIT(); asm volatile("" ::: "memory");
                const float* W = INP(8) + ((size_t)l * DM + 64 * kc) * 6144 + 256 * slab + 4 * C.lane;
                f32x4 acc[5];
#pragma unroll
                for (int ci = 0; ci < 5; ++ci) acc[ci] = (f32x4){0.f, 0.f, 0.f, 0.f};
#pragma unroll 16
                for (int kk = 0; kk < 64; ++kk) { const f32x4 w = *(const f32x4*)(W + (size_t)kk * 6144);
#pragma unroll
                    for (int ci = 0; ci < 5; ++ci) acc[ci] += w * sc[ci * 64 + kk]; }
                float* part = WSP(float, WS_PARTIAL) + ((size_t)(l * 24 + slab) * 16 + kc) * 5 * 256 + 4 * C.lane;
#pragma unroll
                for (int ci = 0; ci < 5; ++ci) *(f32x4*)(part + ci * 256) = acc[ci];
                asm volatile("s_waitcnt vmcnt(0)" ::: "memory");
                unsigned old = 0u;
                if (C.lane == 0) { __builtin_amdgcn_fence(__ATOMIC_RELEASE, "agent"); asm volatile("s_waitcnt vmcnt(0)" ::: "memory");
                    old = __hip_atomic_fetch_add((unsigned*)(C.ws + WS_CTL) + CW_MODCNT + (l * 24 + slab), 1u, __ATOMIC_RELAXED, __HIP_MEMORY_SCOPE_AGENT); }
                old = __builtin_amdgcn_readfirstlane(old);
                if (old == 15u) {
                    __builtin_amdgcn_fence(__ATOMIC_ACQUIRE, "agent"); asm volatile("s_waitcnt vmcnt(0)" ::: "memory");
                    const float* p0 = WSP(float, WS_PARTIAL) + (size_t)(l * 24 + slab) * 16 * 5 * 256 + 4 * C.lane;
                    const f32x4 bm = *(const f32x4*)(INP(9) + (size_t)l * 6144 + 256 * slab + 4 * C.lane);
                    float* dst = WSP(float, WS_MOD) + (size_t)l * 5 * 6144 + 256 * slab + 4 * C.lane;
#pragma unroll
                    for (int ci = 0; ci < 5; ++ci) { f32x4 sum = bm;
#pragma unroll
                        for (int k = 0; k < 16; ++k) sum += *(const f32x4*)(p0 + (size_t)(k * 5 + ci) * 256);
                        *(f32x4*)(dst + ci * 6144) = sum; }
                }
                LDS_WAIT(); asm volatile("" ::: "memory");
                continue;
            }
            const int l = (it - I_MOD) / I_L; int r = (it - I_MOD) % I_L;
            if (r < I_IN) { transpose_item<1>(INP(14) + (size_t)l * DM * NIN, DM, NIN, WSP(bf16, WS_WIN) + (size_t)l * NIN * DM, scr, r, C.lane); continue; } r -= I_IN;
            if (r < I_OUT) { transpose_item<0>(INP(15) + (size_t)l * DM * DM, DM, DM, WSP(bf16, WS_WOUT) + (size_t)l * DM * DM, scr, r, C.lane); continue; } r -= I_OUT;
            if (r < I_G) { transpose_item<2>(INP(28) + (size_t)l * DM * DFF, DM, DFF, WSP(bf16, WS_WGU) + (size_t)l * NGU * DM, scr, r, C.lane); continue; } r -= I_G;
            if (r < I_G) { transpose_item<3>(INP(29) + (size_t)l * DM * DFF, DM, DFF, WSP(bf16, WS_WGU) + (size_t)l * NGU * DM, scr, r, C.lane); continue; } r -= I_G;
            transpose_item<0>(INP(30) + (size_t)l * DFF * DM, DFF, DM, WSP(bf16, WS_WDN) + (size_t)l * DM * DFF, scr, r, C.lane);
        }
    }
    {
        REFRESH_KP();
        const int gt = C.bid * NTHR + C.tid, NGT = C.G * NTHR;
        for (int i = gt; i < 4 * 4 * 64 * 64; i += NGT) { const int c = i & 63, e = (i >> 6) & 63, lg = i >> 12; WSP(bf16, WS_WCT)[i] = (bf16)f2bf(INP(23)[((size_t)lg * 64 + c) * 64 + e]); }
        for (int i = gt; i < 4 * 4 * 128 * 128; i += NGT) WSP(bf16, WS_WSB)[i] = (bf16)f2bf(INP(26)[i]);
        for (int i = gt; i < 64 * 16; i += NGT) { const int pos = i >> 4, f = i & 15; WSP(f32x2v, WS_ROPEA)[i] = rope_cs(pos, f); }
        for (int i = gt; i < 64 * 8; i += NGT) { const int pos = i >> 3, f = i & 7; WSP(f32x2v, WS_ROPEB)[i] = rope_cs(pos, 2 * f); }
        if (gt < 4) { const int l = gt; float s1 = 0.f, s2 = 0.f;
            for (int i = 0; i < 32; ++i) { s1 += INP(18)[l * 32 + i] * INP(19)[l * 32 + i]; s2 += INP(20)[l * 32 + i] * INP(21)[l * 32 + i]; }
            const float lam_init = 0.8f - 0.6f * expf(-0.3f * (float)l);
            WSP(float, WS_LAM)[l] = expf(s1) - expf(s2) + lam_init; }
    }
    {
        REFRESH_KP();
        const int gt = C.bid * NTHR + C.tid, NGT = C.G * NTHR; float* P = WSP(float, WS_PAR);
        for (int i = gt; i < 4096; i += NGT) { P[P_GPREMIX + i] = INP(10)[i]; P[P_GPOSTMIX + i] = INP(11)[i]; P[P_GPREFFN + i] = INP(12)[i]; P[P_GPOSTFFN + i] = INP(13)[i]; }
        for (int i = gt; i < 256; i += NGT) { P[P_AQN + i] = INP(16)[i]; P[P_AKN + i] = INP(17)[i]; P[P_SUBLN + i] = INP(22)[i]; }
        for (int i = gt; i < 1024; i += NGT) { P[P_CSCALE + i] = INP(24)[i]; P[P_DVN + i] = INP(25)[i]; }
        for (int i = gt; i < 2048; i += NGT) P[P_DBS + i] = INP(27)[i];
    }
    prep_caches(C);
}

typedef int i32x4 __attribute__((ext_vector_type(4)));
__device__ __forceinline__ f32x4 ldmod(const float* p, int i4) { return ((const f32x4*)p)[i4]; }
template <bool HAS_Y, bool FROM_IN>
__device__ __forceinline__ void rowwise(const Ctx& C, const bool HAS_H, const float* gate_mod  , const float* gpost, const float* gpre, const float* scale_mod, const float* shift_mod) {
    const int gw = C.bid * NWAVES + C.wave, NGW = C.G * NWAVES;
    const float* Y = WSP(float, WS_Y); bf16* H = WSP(bf16, WS_H);
    for (int row = gw; row < NTOK; row += NGW) {
        const int ci = cond_of_row(row);
        const float* xin = FROM_IN ? (row < NCTX ? INP(0) + (size_t)row * DM : INP(1) + (size_t)(row - NCTX) * DM) : C.out + (size_t)row * DM;
        f32x4 x[4];
#pragma unroll
        for (int j = 0; j < 4; ++j) x[j] = ((const f32x4*)xin)[C.lane + 64 * j];
        if (HAS_Y) {
            f32x4 y[4]; float s = 0.f;
#pragma unroll
            for (int j = 0; j < 4; ++j) { y[j] = ((const f32x4*)(Y + (size_t)row * DM))[C.lane + 64 * j]; s += (y[j][0] * y[j][0] + y[j][1] * y[j][1]) + (y[j][2] * y[j][2] + y[j][3] * y[j][3]); }
            const float r = rsqrtf(wave_sum(s) * (1.f / DM) + EPS);
#pragma unroll
            for (int j = 0; j < 4; ++j) { const f32x4 g = ldmod(gate_mod + (size_t)ci * 6144, C.lane + 64 * j); const f32x4 gp = ((const f32x4*)gpost)[C.lane + 64 * j];
                x[j] = x[j] + g * (y[j] * r * gp); ((f32x4*)(C.out + (size_t)row * DM))[C.lane + 64 * j] = x[j]; }
        }
        if (HAS_H) {
            float s = 0.f;
#pragma unroll
            for (int j = 0; j < 4; ++j) s += (x[j][0] * x[j][0] + x[j][1] * x[j][1]) + (x[j][2] * x[j][2] + x[j][3] * x[j][3]);
            const float r = rsqrtf(wave_sum(s) * (1.f / DM) + EPS);
#pragma unroll
            for (int j = 0; j < 4; ++j) { const f32x4 gp = ((const f32x4*)gpre)[C.lane + 64 * j]; const f32x4 sc = ldmod(scale_mod + (size_t)ci * 6144, C.lane + 64 * j); const f32x4 sh = ldmod(shift_mod + (size_t)ci * 6144, C.lane + 64 * j);
                const f32x4 h = (x[j] * r * gp) * (sc + 1.f) + sh; ((v2u*)(H + (size_t)row * DM))[C.lane + 64 * j] = pk4(h); }
        }
    }
}

template <int MT> struct EpiF32 {
    static constexpr bool PERM = false, AFTER_DRAIN = false;
    float* Y; int ldc;
    __device__ __forceinline__ void operator()(const f32x4 (&acc)[2][2][MT][2], const pg8::Unit& u, int wr, int wc, int fr_in, int fq_in) const {
        int fr = fr_in, fq = fq_in; asm volatile("" : "+v"(fr), "+v"(fq));
#pragma unroll
        for (int ai = 0; ai < 2; ++ai)
#pragma unroll
            for (int m = 0; m < MT; ++m) { float* rowp = Y + (size_t)(u.pm * (64 * MT) + ai * (32 * MT) + wr * (16 * MT) + m * 16 + fr) * ldc + u.pn * 256 + wc * 32 + 4 * fq;
#pragma unroll
                for (int bj = 0; bj < 2; ++bj)
#pragma unroll
                    for (int n = 0; n < 2; ++n) *(f32x4*)(rowp + bj * 128 + n * 16) = acc[ai][bj][m][n]; }
    }
};
template <int MT> struct EpiGLU {
    static constexpr bool PERM = false, AFTER_DRAIN = false;
    bf16* O;
    __device__ __forceinline__ void operator()(const f32x4 (&acc)[2][2][MT][2], const pg8::Unit& u, int wr, int wc, int fr_in, int fq_in) const {
        int fr = fr_in, fq = fq_in; asm volatile("" : "+v"(fr), "+v"(fq));
#pragma unroll
        for (int ai = 0; ai < 2; ++ai)
#pragma unroll
            for (int m = 0; m < MT; ++m) { bf16* rowp = O + (size_t)(u.pm * (64 * MT) + ai * (32 * MT) + wr * (16 * MT) + m * 16 + fr) * DFF + u.pn * 128 + wc * 32 + 4 * fq;
#pragma unroll
                for (int n = 0; n < 2; ++n) { const f32x4 g = acc[ai][0][m][n], up = acc[ai][1][m][n]; f32x4 o;
#pragma unroll
                    for (int e = 0; e < 4; ++e) o[e] = silu_f(g[e]) * up[e];
                    *(v2u*)(rowp + n * 16) = pk4(o); } }
    }
};
template <int MT> struct EpiProj {
    static constexpr bool PERM = false, AFTER_DRAIN = false;
    unsigned char* ws; float* out; int layer;
    __device__ __forceinline__ void operator()(const f32x4 (&acc)[2][2][MT][2], const pg8::Unit& u, int wr, int wc, int fr_in, int fq_in) const {
        int fr = fr_in, fq = fq_in; asm volatile("" : "+v"(fr), "+v"(fq));
        const int pn = u.pn;
        const f32x2v* ropeA = (const f32x2v*)(ws + WS_ROPEA); const f32x2v* ropeB = (const f32x2v*)(ws + WS_ROPEB);
#pragma unroll
        for (int ai = 0; ai < 2; ++ai)
#pragma unroll
            for (int m = 0; m < MT; ++m) {
                const int rowg = u.pm * (64 * MT) + ai * (32 * MT) + wr * (16 * MT) + m * 16, row = rowg + fr;
                const bool lat = rowg >= NCTX;
                int b, s; if (lat) { const int rl = row - NCTX; b = rl >> 11; s = rl & 2047; } else { b = row >> 8; s = row & 255; }
                const int prow = s >> 6, pcol = s & 63;
                f32x4 v[2][2];
#pragma unroll
                for (int bj = 0; bj < 2; ++bj)
#pragma unroll
                    for (int n = 0; n < 2; ++n) v[bj][n] = acc[ai][bj][m][n];
                const int d0 = 4 * fq;
                if (pn == 0 || (pn == 1 && wc < 2)) {
                    float ss = 0.f;
#pragma unroll
                    for (int bj = 0; bj < 2; ++bj)
#pragma unroll
                        for (int n = 0; n < 2; ++n) ss += (v[bj][n][0] * v[bj][n][0] + v[bj][n][1] * v[bj][n][1]) + (v[bj][n][2] * v[bj][n][2] + v[bj][n][3] * v[bj][n][3]);
                    ss += __shfl_xor(ss, 16); ss += __shfl_xor(ss, 32);
                    const float r = rsqrtf(ss * (1.f / 64.f) + EPS);
                    const float* gn = (const float*)(ws + WS_PAR) + (pn == 0 ? P_AQN : P_AKN) + 64 * layer;
#pragma unroll
                    for (int bj = 0; bj < 2; ++bj)
#pragma unroll
                        for (int n = 0; n < 2; ++n) v[bj][n] = v[bj][n] * r * *(const f32x4*)(gn + 32 * bj + 16 * n + d0);
                    if (pn == 1 && !lat) {
                        float* o = out + OUT_AK + (((size_t)(b * 4 + layer) * 256 + s) * 128 + 64 * wc);
#pragma unroll
                        for (int bj = 0; bj < 2; ++bj)
#pragma unroll
                            for (int n = 0; n < 2; ++n) *(f32x4*)(o + 32 * bj + 16 * n + d0) = v[bj][n];
                    }
                    if (lat) {
#pragma unroll
                        for (int bj = 0; bj < 2; ++bj) { const int pos = bj == 0 ? prow : pcol;
#pragma unroll
                            for (int e = 0; e < 4; ++e) { const f32x2v cs = ropeA[pos * 16 + d0 + e]; const float x1 = v[bj][0][e], x2 = v[bj][1][e];
                                v[bj][0][e] = x1 * cs.x - x2 * cs.y; v[bj][1][e] = x2 * cs.x + x1 * cs.y; } }
                    }
                    if (pn == 0) {
                        bf16* o = (bf16*)(ws + WS_QA) + (size_t)row * 256 + 64 * wc;
#pragma unroll
                        for (int bj = 0; bj < 2; ++bj)
#pragma unroll
                            for (int n = 0; n < 2; ++n) *(v2u*)(o + 32 * bj + 16 * n + d0) = pk4(v[bj][n] * QSCALE_A);
                    } else {
                        bf16* o = (bf16*)(ws + WS_KA) + (lat ? KA_LAT + ((size_t)(b * 2 + wc) * SEQL + s) * 64 : ((size_t)(b * 2 + wc) * 256 + s) * 64);
#pragma unroll
                        for (int bj = 0; bj < 2; ++bj)
#pragma unroll
                            for (int n = 0; n < 2; ++n) *(v2u*)(o + 32 * bj + 16 * n + d0) = pk4(v[bj][n]);
                    }
                } else if (pn == 1) {
                    const int h = wc - 2;
                    if (!lat) { float* o = out + OUT_AV + (((size_t)(b * 4 + layer) * 256 + s) * 128 + 64 * h);
#pragma unroll
                        for (int bj = 0; bj < 2; ++bj)
#pragma unroll
                            for (int n = 0; n < 2; ++n) *(f32x4*)(o + 32 * bj + 16 * n + d0) = v[bj][n]; }
                    bf16* o = (bf16*)(ws + WS_VAT) + (lat ? KA_LAT + (size_t)(b * 2 + h) * 64 * SEQL + s : (size_t)(b * 2 + h) * 64 * 256 + s);
                    const int pitch = lat ? SEQL : 256;
#pragma unroll
                    for (int bj = 0; bj < 2; ++bj)
#pragma unroll
                        for (int n = 0; n < 2; ++n)
#pragma unroll
                            for (int e = 0; e < 4; ++e) o[(size_t)(32 * bj + 16 * n + d0 + e) * pitch] = (bf16)f2bf(v[bj][n][e]);
                } else if (pn == 2 || pn == 3) {
                    if (pn == 3 && !lat) { float* o = out + OUT_BK + (((size_t)(b * 4 + layer) * 256 + s) * 256 + 64 * wc);
#pragma unroll
                        for (int bj = 0; bj < 2; ++bj)
#pragma unroll
                            for (int n = 0; n < 2; ++n) *(f32x4*)(o + 32 * bj + 16 * n + d0) = v[bj][n]; }
                    if (lat) {
#pragma unroll
                        for (int bj = 0; bj < 2; ++bj)
#pragma unroll
                            for (int n = 0; n < 2; ++n) { const int pos = n == 0 ? prow : pcol;
#pragma unroll
                                for (int e = 0; e < 4; ++e) { const f32x2v cs = ropeB[pos * 8 + 4 * (fq & 1) + e]; const float mine = v[bj][n][e]; const float other = __shfl_xor(mine, 32);
                                    v[bj][n][e] = fq < 2 ? mine * cs.x - other * cs.y : mine * cs.x + other * cs.y; } }
                    }
                    if (pn == 2) { bf16* o = (bf16*)(ws + WS_QB) + (size_t)row * 256 + 64 * wc;
#pragma unroll
                        for (int bj = 0; bj < 2; ++bj)
#pragma unroll
                            for (int n = 0; n < 2; ++n) *(v2u*)(o + 32 * bj + 16 * n + d0) = pk4(v[bj][n] * QSCALE_B);
                    } else { bf16* o = (bf16*)(ws + WS_KB) + (lat ? KB_LAT + ((size_t)(b * 4 + wc) * SEQL + s) * 64 : ((size_t)(b * 4 + wc) * 256 + s) * 64);
#pragma unroll
                        for (int bj = 0; bj < 2; ++bj)
#pragma unroll
                            for (int n = 0; n < 2; ++n) *(v2u*)(o + 32 * bj + 16 * n + d0) = pk4(v[bj][n]); }
                } else if (pn == 4) {
                    if (!lat) { float* o = out + OUT_BV + (((size_t)(b * 4 + layer) * 256 + s) * 256 + 64 * wc);
#pragma unroll
                        for (int bj = 0; bj < 2; ++bj)
#pragma unroll
                            for (int n = 0; n < 2; ++n) *(f32x4*)(o + 32 * bj + 16 * n + d0) = v[bj][n]; }
                    bf16* o = (bf16*)(ws + WS_VBT) + (lat ? KB_LAT + (size_t)(b * 4 + wc) * 64 * SEQL + s : (size_t)(b * 4 + wc) * 64 * 256 + s);
                    const int pitch = lat ? SEQL : 256;
#pragma unroll
                    for (int bj = 0; bj < 2; ++bj)
#pragma unroll
                        for (int n = 0; n < 2; ++n)
#pragma unroll
                            for (int e = 0; e < 4; ++e) o[(size_t)(32 * bj + 16 * n + d0 + e) * pitch] = (bf16)f2bf(v[bj][n][e]);
                } else {
                    bf16* o = (bf16*)(ws + (pn == 5 ? WS_CX : pn == 6 ? WS_U : WS_V)) + (size_t)row * 256 + 64 * wc;
#pragma unroll
                    for (int bj = 0; bj < 2; ++bj)
#pragma unroll
                        for (int n = 0; n < 2; ++n) { f32x4 t = v[bj][n];
                            if (pn != 5) {
#pragma unroll
                                for (int e = 0; e < 4; ++e) t[e] = gelu_tanh(t[e]); }
                            *(v2u*)(o + 32 * bj + 16 * n + d0) = pk4(t); }
                }
            }
    }
};

constexpr int KS_STRIDE = 72, VS_STRIDE = 68, VS_OFF = 9216;
#define MFMA32(a, b, c) __builtin_amdgcn_mfma_f32_32x32x16_bf16(a, b, c, 0, 0, 0)
#define MFMA16(a, b, c) __builtin_amdgcn_mfma_f32_16x16x32_bf16(a, b, c, 0, 0, 0)

__device__ __forceinline__ bf16x8 pack8(const f32x16& p, int s) {
    v4u r; r.x = pkbf(p[8 * s + 0], p[8 * s + 1]); r.y = pkbf(p[8 * s + 2], p[8 * s + 3]); r.z = pkbf(p[8 * s + 4], p[8 * s + 5]); r.w = pkbf(p[8 * s + 6], p[8 * s + 7]);
    return __builtin_bit_cast(bf16x8, r);
}
__device__ __forceinline__ float max16(const f32x16& s) {
    float a = fmaxf(fmaxf(s[0], s[1]), fmaxf(s[2], s[3])), b = fmaxf(fmaxf(s[4], s[5]), fmaxf(s[6], s[7]));
    float c = fmaxf(fmaxf(s[8], s[9]), fmaxf(s[10], s[11])), d = fmaxf(fmaxf(s[12], s[13]), fmaxf(s[14], s[15]));
    return fmaxf(fmaxf(a, b), fmaxf(c, d));
}
constexpr float SUM_LIM = 4096.f;
template <bool REL>
__device__ __forceinline__ bool softmax_fast(f32x16& sa, f32x16& sb, float& l_run, float m_run) {
    float sum = 0.f;
#pragma unroll
    for (int i = 0; i < 16; ++i) { sa[i] = __builtin_amdgcn_exp2f(REL ? sa[i] : sa[i] - m_run); sb[i] = __builtin_amdgcn_exp2f(REL ? sb[i] : sb[i] - m_run); sum += sa[i] + sb[i]; }
    const bool ok = __all(sum <= SUM_LIM);
    if (ok) l_run += sum;
    return ok;
}
template <int NO, bool REL>
__device__ __forceinline__ void softmax_slow(f32x16& sa, f32x16& sb, float& m_run, f32x16& nm, float& l_run, f32x16 (&O)[NO], bool first) {
    float mx = fmaxf(max16(sa), max16(sb)); mx = fmaxf(mx, __shfl_xor(mx, 32));
    if (!REL) mx -= m_run;
    const float d = first ? mx : fmaxf(mx, 0.f);
    if (!REL) {
#pragma unroll
        for (int i = 0; i < 16; ++i) { sa[i] -= m_run; sb[i] -= m_run; } }
    m_run += d;
    if (REL) {
#pragma unroll
        for (int i = 0; i < 16; ++i) nm[i] = -m_run; }
    if (!first) { const float alpha = __builtin_amdgcn_exp2f(-d); l_run *= alpha;
#pragma unroll
        for (int k = 0; k < NO; ++k) O[k] = O[k] * alpha; }
    float sum = 0.f;
#pragma unroll
    for (int i = 0; i < 16; ++i) { sa[i] = __builtin_amdgcn_exp2f(sa[i] - d); sb[i] = __builtin_amdgcn_exp2f(sb[i] - d); sum += sa[i] + sb[i]; }
    l_run += sum;
}
constexpr int ATT_TILE = 8192, ATT_BUF = 2 * ATT_TILE;
template <int NK>
__device__ __forceinline__ void score_map(const LAS bf16* Ks, int r, int hh, int swz, int c0, const bf16x8* qf, const f32x16& nm, f32x16& sa, f32x16& sb) {
    sa = nm; sb = nm;
#pragma unroll
    for (int kk = 0; kk < NK; ++kk) {
        const int pc = ((c0 + 2 * kk + hh) ^ swz) * 8;
        const bf16x8 ka = *(const LAS bf16x8*)(Ks + r * 64 + pc), kb = *(const LAS bf16x8*)(Ks + (32 + r) * 64 + pc);
        sa = MFMA32(ka, qf[kk], sa); sb = MFMA32(kb, qf[kk], sb); }
}
__device__ __forceinline__ bf16x8 ld_vfrag(const LAS bf16* vrow, int s, int hh, int swz) {
    const v2u lo = *(const LAS v2u*)(vrow + ((2 * s) ^ swz) * 8 + 4 * hh), hi = *(const LAS v2u*)(vrow + ((2 * s + 1) ^ swz) * 8 + 4 * hh);
    return __builtin_bit_cast(bf16x8, (v4u){lo.x, lo.y, hi.x, hi.y});
}
template <bool DIFF>
__device__ __forceinline__ void attn_unit(const Ctx& C, const bf16* Q  , const bf16* K0, const bf16* VT0, int pitch0, int nt0, const bf16* K1, const bf16* VT1, int pitch1, int nt1,
                                          bf16* O  , float lam, float post_scale, const float* subln, gu32* head, unsigned& nxt) {
    const int r = C.lane & 31, hh = C.lane >> 5, w = C.wave, swz = (r >> 1) & 7;
    const bf16* qrow = Q + (size_t)(32 * w + r) * 256;
    bf16x8 qf[4];
#pragma unroll
    for (int kk = 0; kk < 4; ++kk) qf[kk] = *(const bf16x8*)(qrow + 16 * kk + 8 * hh);
    f32x16 O0[2], O1[2], nm0;
#pragma unroll
    for (int i = 0; i < 16; ++i) { O0[0][i] = 0.f; O0[1][i] = 0.f; O1[0][i] = 0.f; O1[1][i] = 0.f; nm0[i] = 0.f; }
    float m0 = 0.f, l0 = 0.f, m1 = 0.f, l1 = 0.f;
    const int nt = nt0 + nt1;
    const int drow = 8 * w + (C.lane >> 3), dch = ((C.lane & 7) ^ ((drow >> 1) & 7)) * 8;
    const LAS unsigned char* ldsw = C.lds + w * 1024;
#define ATT_DMA(tl) do { const int tg = (tl); const bool s0 = tg < nt0; const int tt = s0 ? tg : tg - nt0; const bf16* Kp = s0 ? K0 : K1; const bf16* Vp = s0 ? VT0 : VT1; const int pitch = s0 ? pitch0 : pitch1; const int bo = (tg % 3) * ATT_BUF; \
        __builtin_amdgcn_global_load_lds((const unsigned*)(Kp + (size_t)(64 * tt + drow) * 64 + dch), (LAS unsigned*)(ldsw + bo), 16, 0, 0); \
        __builtin_amdgcn_global_load_lds((const unsigned*)(Vp + (size_t)drow * pitch + 64 * tt + dch), (LAS unsigned*)(ldsw + bo + ATT_TILE), 16, 0, 0); } while (0)
    __syncthreads();
    ATT_DMA(0);
    if (nt > 1) ATT_DMA(1);
#pragma unroll 1
    for (int t = 0; t < nt; ++t) {
        if (t + 1 < nt) asm volatile("s_waitcnt vmcnt(2)" ::: "memory"); else asm volatile("s_waitcnt vmcnt(0)" ::: "memory");
        __builtin_amdgcn_s_barrier();
        asm volatile("" ::: "memory");
        if (t + 2 < nt) ATT_DMA(t + 2);
        const LAS bf16* Ks = (const LAS bf16*)(C.lds + (t % 3) * ATT_BUF); const LAS bf16* Vs = (const LAS bf16*)(C.lds + (t % 3) * ATT_BUF + ATT_TILE);
        f32x16 sa, sb;
        if (!DIFF) {
            score_map<4>(Ks, r, hh, swz, 0, qf, nm0, sa, sb);
            if (t == 0 || !softmax_fast<true>(sa, sb, l0, 0.f)) { score_map<4>(Ks, r, hh, swz, 0, qf, nm0, sa, sb); softmax_slow<2, true>(sa, sb, m0, nm0, l0, O0, t == 0); }
#pragma unroll
            for (int s = 0; s < 4; ++s) {
                const bf16x8 pf = s < 2 ? pack8(sa, s) : pack8(sb, s - 2);
#pragma unroll
                for (int dt = 0; dt < 2; ++dt) O0[dt] = MFMA32(ld_vfrag(Vs + (32 * dt + r) * 64, s, hh, swz), pf, O0[dt]);
            }
        } else {
            score_map<2>(Ks, r, hh, swz, 0, qf, nm0, sa, sb);
            if (t == 0 || !softmax_fast<false>(sa, sb, l0, m0)) { score_map<2>(Ks, r, hh, swz, 0, qf, nm0, sa, sb); softmax_slow<2, false>(sa, sb, m0, nm0, l0, O0, t == 0); }
            bf16x8 pf0[4]; pf0[0] = pack8(sa, 0); pf0[1] = pack8(sa, 1); pf0[2] = pack8(sb, 0); pf0[3] = pack8(sb, 1);
            __builtin_amdgcn_sched_barrier(0);
            score_map<2>(Ks, r, hh, swz, 4, qf + 2, nm0, sa, sb);
            if (t == 0 || !softmax_fast<false>(sa, sb, l1, m1)) { score_map<2>(Ks, r, hh, swz, 4, qf + 2, nm0, sa, sb); softmax_slow<2, false>(sa, sb, m1, nm0, l1, O1, t == 0); }
#pragma unroll
            for (int s = 0; s < 4; ++s) {
                const bf16x8 pf1 = s < 2 ? pack8(sa, s) : pack8(sb, s - 2);
#pragma unroll
                for (int dt = 0; dt < 2; ++dt) { const bf16x8 vf = ld_vfrag(Vs + (32 * dt + r) * 64, s, hh, swz); O0[dt] = MFMA32(vf, pf0[s], O0[dt]); O1[dt] = MFMA32(vf, pf1, O1[dt]); }
            }
        }
    }
#undef ATT_DMA
    if (C.tid == 0) nxt = __hip_atomic_fetch_add(head, 1u, RLX_AGENT);
    l0 += __shfl_xor(l0, 32); const float inv0 = 1.f / l0;
    bf16* orow = O + (size_t)(32 * w + r) * DM;
    if (!DIFF) {
#pragma unroll
        for (int dt = 0; dt < 2; ++dt)
#pragma unroll
            for (int g = 0; g < 4; ++g) { f32x4 o = {O0[dt][4 * g] * inv0, O0[dt][4 * g + 1] * inv0, O0[dt][4 * g + 2] * inv0, O0[dt][4 * g + 3] * inv0};
                *(v2u*)(orow + 32 * dt + 8 * g + 4 * hh) = pk4(o); }
    } else {
        l1 += __shfl_xor(l1, 32); const float inv1 = lam / l1;
        float ss = 0.f;
#pragma unroll
        for (int dt = 0; dt < 2; ++dt)
#pragma unroll
            for (int i = 0; i < 16; ++i) { const float o = O0[dt][i] * inv0 - O1[dt][i] * inv1; O0[dt][i] = o; ss += o * o; }
        ss += __shfl_xor(ss, 32);
        const float rr = rsqrtf(ss * (1.f / 64.f) + EPS) * post_scale;
#pragma unroll
        for (int dt = 0; dt < 2; ++dt)
#pragma unroll
            for (int g = 0; g < 4; ++g) { const f32x4 gn = *(const f32x4*)(subln + 32 * dt + 8 * g + 4 * hh);
                f32x4 o = {O0[dt][4 * g] * rr * gn[0], O0[dt][4 * g + 1] * rr * gn[1], O0[dt][4 * g + 2] * rr * gn[2], O0[dt][4 * g + 3] * rr * gn[3]};
                *(v2u*)(orow + 32 * dt + 8 * g + 4 * hh) = pk4(o); }
    }
}

__device__ __forceinline__ void pool_unit(const Ctx& C, int row0, int layer, gu32* head, unsigned& nxt) {
    constexpr int XS = 264;
    LAS bf16* xs = (LAS bf16*)C.lds;
    LAS bf16* pl = (LAS bf16*)(C.lds + 80 * XS * 2);
    const bf16* CX = WSP(bf16, WS_CX);
    int S, bstart; if (row0 < NCTX) { S = SEQC; bstart = row0 & ~255; } else { S = SEQL; bstart = NCTX + ((row0 - NCTX) & ~2047); }
    const int t0 = row0 - bstart;
    if (C.tid == 0) nxt = __hip_atomic_fetch_add(head, 1u, RLX_AGENT);
    v4u cxr[5];
#pragma unroll
    for (int k = 0; k < 5; ++k) { const int i = C.tid + NTHR * k, rr = i >> 5, ch = i & 31; const int t = t0 - 8 + rr;
        cxr[k] = (v4u){0u, 0u, 0u, 0u}; if (t >= 0 && t < S) cxr[k] = *(const v4u*)(CX + (size_t)(bstart + t) * 256 + 8 * ch); }
    bf16x8 wfp[2][4];
    { const bf16* WCT = WSP(bf16, WS_WCT) + (size_t)(layer * 4 + (C.wave >> 1)) * 4096 + (C.lane & 15) * 64 + 8 * (C.lane >> 4);
#pragma unroll
      for (int kk = 0; kk < 2; ++kk)
#pragma unroll
          for (int nt = 0; nt < 4; ++nt) wfp[kk][nt] = *(const bf16x8*)(WCT + (16 * nt) * 64 + 32 * kk); }
    __syncthreads();
#pragma unroll
    for (int k = 0; k < 5; ++k) { const int i = C.tid + NTHR * k, rr = i >> 5, ch = i & 31; *(LAS v4u*)(xs + rr * XS + 8 * ch) = cxr[k]; }
    __syncthreads();
    {
        const int cp = C.tid & 127, tq = C.tid >> 7, g = cp >> 5, half = 1 << g;
        for (int tt = 0; tt < 16; ++tt) { const int tl = tq * 16 + tt, t = t0 + tl;
            const int lo = max(t - half, 0), hi = min(t + half, S); float s0 = 0.f, s1 = 0.f;
            for (int k = lo; k < hi; ++k) { const unsigned pv = *(const LAS unsigned*)(xs + (k - t0 + 8) * XS + 2 * cp); s0 += bf2f((unsigned short)(pv & 0xffff)); s1 += bf2f((unsigned short)(pv >> 16)); }
            const unsigned cv = *(const LAS unsigned*)(xs + (tl + 8) * XS + 2 * cp); const float inv = 1.f / (float)(hi - lo);
            *(LAS unsigned*)(pl + tl * XS + 2 * cp) = pkbf(s0 * inv - bf2f((unsigned short)(cv & 0xffff)), s1 * inv - bf2f((unsigned short)(cv >> 16))); }
    }
    __syncthreads();
    {
        const int g = C.wave >> 1, mh = C.wave & 1, fr = C.lane & 15, fq = C.lane >> 4;
        f32x4 acc[2][4];
#pragma unroll
        for (int mt = 0; mt < 2; ++mt)
#pragma unroll
            for (int nt = 0; nt < 4; ++nt) acc[mt][nt] = (f32x4){0.f, 0.f, 0.f, 0.f};
#pragma unroll
        for (int kk = 0; kk < 2; ++kk) {
            bf16x8 xf[2];
#pragma unroll
            for (int mt = 0; mt < 2; ++mt) xf[mt] = *(const LAS bf16x8*)(pl + (32 * mh + 16 * mt + fr) * XS + 64 * g + 32 * kk + 8 * fq);
#pragma unroll
            for (int mt = 0; mt < 2; ++mt)
#pragma unroll
                for (int nt = 0; nt < 4; ++nt) acc[mt][nt] = MFMA16(wfp[kk][nt], xf[mt], acc[mt][nt]);
        }
        const float* cs = WSP(float, WS_PAR) + P_CSCALE + layer * 256 + 64 * g;
        bf16* MIX = WSP(bf16, WS_MIX);
#pragma unroll
        for (int mt = 0; mt < 2; ++mt)
#pragma unroll
            for (int nt = 0; nt < 4; ++nt) { const f32x4 sc = *(const f32x4*)(cs + 16 * nt + 4 * fq);
                *(v2u*)(MIX + (size_t)(row0 + 32 * mh + 16 * mt + fr) * DM + 512 + 64 * g + 16 * nt + 4 * fq) = pk4(acc[mt][nt] * sc); }
    }
}

typedef short s16x4 __attribute__((ext_vector_type(4)));
__device__ __forceinline__ bf16x8 tr_frag(const LAS bf16* p0, const LAS bf16* p1) {
    const s16x4 lo = __builtin_amdgcn_ds_read_tr16_b64_v4i16((LAS s16x4*)p0), hi = __builtin_amdgcn_ds_read_tr16_b64_v4i16((LAS s16x4*)p1);
    return (bf16x8){lo[0], lo[1], lo[2], lo[3], hi[0], hi[1], hi[2], hi[3]};
}
__device__ __forceinline__ void gate_unit(const Ctx& C, int row0, int layer, gu32* head, unsigned& nxt) {
    constexpr int VS = 272;
    LAS bf16* vs = (LAS bf16*)C.lds;
    const bf16* V = WSP(bf16, WS_V); const bf16* U = WSP(bf16, WS_U);
    if (C.tid == 0) nxt = __hip_atomic_fetch_add(head, 1u, RLX_AGENT);
    const int q = C.tid >> 2, qu = C.tid & 3;
    const int g = C.wave >> 1, ph = C.wave & 1, fr = C.lane & 15, fq = C.lane >> 4;
    v4u raw[8];
    { const bf16* src = V + (size_t)(row0 + q) * 256 + 64 * qu;
#pragma unroll
      for (int i = 0; i < 8; ++i) raw[i] = *(const v4u*)(src + 8 * i); }
    bf16x8 wf[4][4];
    { const bf16* WS_ = WSP(bf16, WS_WSB) + (size_t)(layer * 4 + g) * 16384 + (size_t)(64 * ph + fr) * 128 + 8 * fq;
#pragma unroll
      for (int kk = 0; kk < 4; ++kk)
#pragma unroll
          for (int pt = 0; pt < 4; ++pt) wf[kk][pt] = *(const bf16x8*)(WS_ + (16 * pt) * 128 + 32 * kk); }
    float ss = 0.f;
#pragma unroll
    for (int i = 0; i < 8; ++i)
#pragma unroll
        for (int j = 0; j < 4; ++j) { const float a = bf2f((unsigned short)(raw[i][j] & 0xffff)), b = bf2f((unsigned short)(raw[i][j] >> 16)); ss += a * a + b * b; }
    ss += __shfl_xor(ss, 1); ss += __shfl_xor(ss, 2);
    const float r = rsqrtf(ss * (1.f / 256.f) + EPS);
    __syncthreads();
#pragma unroll
    for (int i = 0; i < 8; ++i) { v4u o;
#pragma unroll
        for (int j = 0; j < 4; ++j) o[j] = pkbf(bf2f((unsigned short)(raw[i][j] & 0xffff)) * r, bf2f((unsigned short)(raw[i][j] >> 16)) * r);
        *(LAS v4u*)(vs + q * VS + 64 * qu + 8 * i) = o; }
    __syncthreads();
    int opq = 0; asm volatile("" : "+v"(opq) :: "memory");
    f32x4 acc[4][4];
#pragma unroll
    for (int pt = 0; pt < 4; ++pt)
#pragma unroll
        for (int ct = 0; ct < 4; ++ct) acc[pt][ct] = (f32x4){0.f, 0.f, 0.f, 0.f};
#pragma unroll
    for (int kk = 0; kk < 4; ++kk) {
#pragma unroll
        for (int ct = 0; ct < 4; ++ct) {
            const LAS bf16* p0 = vs + opq + (32 * kk + 8 * fq + (fr >> 2)) * VS + 64 * g + 16 * ct + 4 * (fr & 3);
            const bf16x8 vf = tr_frag(p0, p0 + 4 * VS);
#pragma unroll
            for (int pt = 0; pt < 4; ++pt) acc[pt][ct] = MFMA16(vf, wf[kk][pt], acc[pt][ct]);
        }
    }
    bf16* MIX = WSP(bf16, WS_MIX);
    const float* gv = WSP(float, WS_PAR) + P_DVN + layer * 256 + 64 * g + 4 * fq;
#pragma unroll
    for (int pt = 0; pt < 4; ++pt) { const int p = 64 * ph + 16 * pt + fr; const float bs = WSP(float, WS_PAR)[P_DBS + (layer * 4 + g) * 128 + p];
#pragma unroll
        for (int ct = 0; ct < 4; ++ct) { const v2u ur = *(const v2u*)(U + (size_t)(row0 + p) * 256 + 64 * g + 16 * ct + 4 * fq); const f32x4 gn = *(const f32x4*)(gv + 16 * ct);
            f32x4 o; o[0] = bf2f((unsigned short)(ur.x & 0xffff)) * (acc[pt][ct][0] * gn[0] + bs); o[1] = bf2f((unsigned short)(ur.x >> 16)) * (acc[pt][ct][1] * gn[1] + bs);
            o[2] = bf2f((unsigned short)(ur.y & 0xffff)) * (acc[pt][ct][2] * gn[2] + bs); o[3] = bf2f((unsigned short)(ur.y >> 16)) * (acc[pt][ct][3] * gn[3] + bs);
            *(v2u*)(MIX + (size_t)(row0 + p) * DM + 768 + 64 * g + 16 * ct + 4 * fq) = pk4(o); } }
}

constexpr int U_LATB = 128, U_LATA = 128, U_CTXB = 64, U_CTXA = 64, U_GATE = 96, U_POOL = 192, U_TOTAL = U_LATB + U_LATA + U_CTXB + U_CTXA + U_GATE + U_POOL;
__device__ __forceinline__ void mixer_phase(const Ctx& Cm, int qidx, unsigned mask) {
    const int layer = qidx & 3;
    volatile LAS unsigned* slot = (volatile LAS unsigned*)(Cm.lds + MISC_OFF + 64);
    gu32* head = (gu32*)(Cm.ws + WS_CTL) + CW_QUEUE + 64 * qidx;
    const float lam = ((const float*)(Cm.ws + WS_LAM))[layer];
    const float lam_init = 0.8f - 0.6f * expf(-0.3f * (float)layer);
    unsigned nxt = 0u;
    if (Cm.tid == 0) nxt = __hip_atomic_fetch_add(head, 1u, RLX_AGENT);
    for (int guard = 0; guard < 4096; ++guard) {
        __syncthreads();
        if (Cm.tid == 0) slot[0] = nxt;
        __syncthreads();
        int u = __builtin_amdgcn_readfirstlane((int)slot[0]);
        if (u >= U_TOTAL) break;
        { const int cls = u < U_LATB ? 0 : u < U_LATB + U_LATA ? 1 : u < U_LATB + U_LATA + U_CTXB ? 2 : u < U_LATB + U_LATA + U_CTXB + U_CTXA ? 3 : u < U_LATB + U_LATA + U_CTXB + U_CTXA + U_GATE ? 4 : 5; if (!((mask >> cls) & 1u)) { if (Cm.tid == 0) nxt = __hip_atomic_fetch_add(head, 1u, RLX_AGENT); continue; } }
        Ctx C = Cm; asm volatile("" : "+s"(C.ws), "+v"(C.tid)); C.lane = C.tid & 63; C.wave = __builtin_amdgcn_readfirstlane(C.tid >> 6);
        const float* subln = WSP(float, WS_PAR) + P_SUBLN + layer * 64;
        bf16* MIX = WSP(bf16, WS_MIX);
        if (u < U_LATB + U_LATA + U_CTXB + U_CTXA) {
            bool diff, lat; int b, h, row0;
            if (u < U_LATB) { diff = true; lat = true; b = u >> 5; h = (u >> 3) & 3; row0 = NCTX + b * SEQL + 256 * (u & 7); }
            else if (u < U_LATB + U_LATA) { const int v = u - U_LATB; diff = false; lat = true; b = v >> 5; h = (v >> 3) & 3; row0 = NCTX + b * SEQL + 256 * (v & 7); }
            else if (u < U_LATB + U_LATA + U_CTXB) { const int v = u - U_LATB - U_LATA; diff = true; lat = false; b = v >> 2; h = v & 3; row0 = 256 * b; }
            else { const int v = u - U_LATB - U_LATA - U_CTXB; diff = false; lat = false; b = v >> 2; h = v & 3; row0 = 256 * b; }
            if (diff) {
#ifndef SKIP_ATT_B
                const size_t hn = (size_t)b * 4 + h, hc = (size_t)(layer * 4 + b) * 4 + h;
                const bf16* K0 = lat ? WSP(bf16, WS_KBC) + hc * 256 * 64 : WSP(bf16, WS_KB) + hn * 256 * 64;
                const bf16* V0 = lat ? WSP(bf16, WS_VBTC) + hc * 64 * 256 : WSP(bf16, WS_VBT) + hn * 64 * 256;
                attn_unit<true>(C, WSP(bf16, WS_QB) + (size_t)row0 * 256 + 64 * h, K0, V0, 256, 4,
                                WSP(bf16, WS_KB) + KB_LAT + hn * SEQL * 64, WSP(bf16, WS_VBT) + KB_LAT + hn * 64 * SEQL, SEQL, lat ? 32 : 0,
                                MIX + (size_t)row0 * DM + 256 + 64 * h, lam, 1.f - lam_init, subln, head, nxt);
#endif
            } else {
#ifndef SKIP_ATT_A
                const int kvh = h >> 1; const size_t hn = (size_t)b * 2 + kvh, hc = (size_t)(layer * 4 + b) * 2 + kvh;
                const bf16* K0 = lat ? WSP(bf16, WS_KAC) + hc * 256 * 64 : WSP(bf16, WS_KA) + hn * 256 * 64;
                const bf16* V0 = lat ? WSP(bf16, WS_VATC) + hc * 64 * 256 : WSP(bf16, WS_VAT) + hn * 64 * 256;
                attn_unit<false>(C, WSP(bf16, WS_QA) + (size_t)row0 * 256 + 64 * h, K0, V0, 256, 4,
                                 WSP(bf16, WS_KA) + KA_LAT + hn * SEQL * 64, WSP(bf16, WS_VAT) + KA_LAT + hn * 64 * SEQL, SEQL, lat ? 32 : 0,
                                 MIX + (size_t)row0 * DM + 64 * h, 0.f, 1.f, subln, head, nxt);
#endif
            }
            continue;
        }
        u -= U_LATB + U_LATA + U_CTXB;
        u -= U_CTXA;
#ifndef SKIP_GATE
        if (u < U_GATE) { gate_unit(C, 128 * u, layer, head, nxt); continue; }
#endif
        u -= U_GATE;
#ifndef SKIP_POOL
        if (u >= 0) pool_unit(C, 64 * u, layer, head, nxt);
#endif
    }
}

__global__ void __launch_bounds__(NTHR, 2) fwd_kernel(KArgs args) {
    extern __shared__ __attribute__((aligned(16))) unsigned char lds_raw[];
    Ctx C;
    C.kp = (const CAS unsigned long long*)__builtin_amdgcn_kernarg_segment_ptr();
    C.out = args.out; C.ws = args.ws;
    C.lds = (LAS unsigned char*)lds_raw; C.tid = threadIdx.x; C.lane = C.tid & 63; C.wave = __builtin_amdgcn_readfirstlane(C.tid >> 6); C.G = gridDim.x; C.bid = blockIdx.x;
    for (int u = C.tid; u < (LDS_BYTES - LDSCTL_OFF) / 4; u += NTHR) ((LAS unsigned*)(C.lds + LDSCTL_OFF))[u] = 0u;
    __syncthreads();
    XcdBarrier bar = xcd_barrier_post((unsigned*)(C.ws + WS_CTL) + CW_BAR, (volatile LAS unsigned*)(C.lds + MISC_OFF) + 8);
#define GRID_BAR() xcd_barrier(bar)

    const Ctx C0 = C;
#ifdef TIME_SEL
    const bool diag_fresh = __hip_atomic_load((unsigned*)(C0.ws + WS_PAR + 512 * 1024), __ATOMIC_RELAXED, __HIP_MEMORY_SCOPE_AGENT) != 0x5eed1234u;
#endif
#define PHASE_CTX() Ctx C = C0; asm volatile("" : "+s"(C.ws), "+s"(C.out), "+s"(C.G), "+s"(C.bid), "+v"(C.tid)); C.lane = C.tid & 63; C.wave = __builtin_amdgcn_readfirstlane(C.tid >> 6)
    constexpr int NSTEPS = 2 + 7 * DEPTH_L;
#ifndef GEMM_MT
#define GEMM_MT 3
#endif
#ifndef GEMM3_MT
#define GEMM3_MT 3
#endif
    constexpr int GMT = GEMM_MT, GMT3 = GEMM3_MT;
#ifndef REP_G1
#define REP_G1 1
#endif
#ifndef REP_MIX
#define REP_MIX 1
#endif
#ifndef REP_MASK
#define REP_MASK 63
#endif
#ifndef REP_G24
#define REP_G24 1
#endif
#ifndef REP_G3
#define REP_G3 1
#endif
#pragma unroll 1
    for (int step = 0; step < NSTEPS; ++step) {
        const int l = step < 2 ? 0 : (step - 2) / 7, kind = step < 2 ? step : 2 + (step - 2) % 7;
#ifdef TIME_SEL
        unsigned long long t_start = 0ull; if (C0.bid == 0 && C0.tid == 0) t_start = __builtin_amdgcn_s_memrealtime();
#endif
        const int nrep = kind == 2 ? REP_G1 : kind == 3 ? REP_MIX : (kind == 4 || kind == 7) ? REP_G24 : kind == 6 ? REP_G3 : 1;
#pragma unroll 1
        for (int rep = 0; rep < nrep; ++rep) {
        if (kind == 0) {
#ifndef SKIP_P0
            PHASE_CTX(); phase0(C);
#endif
        } else if (kind == 1) {
            PHASE_CTX(); const float* mod = WSP(float, WS_MOD);
            rowwise<false, true>(C, true, nullptr, nullptr, WSP(float, WS_PAR) + P_GPREMIX, mod + 1 * 1024, mod + 0 * 1024);
        } else if (kind == 2) {
            PHASE_CTX();
            pg8::Gemm g{WSP(bf16, WS_H), WSP(bf16, WS_WIN) + (size_t)l * NIN * DM, NTOK, NIN, DM}; pg8::StaticOrder S; S.init(NTOK, NIN, C.G, C.bid, 64 * GMT);
            EpiProj<GMT> E{C.ws, C.out, l};
#ifndef SKIP_G1
            pg8::gemm_phase<EpiProj<GMT>, pg8::StaticOrder, true, true, GMT>(C.lds, g, S, E, C.tid);
#endif
        } else if (kind == 3) {
#ifndef SKIP_MIX
            PHASE_CTX(); mixer_phase(C, l + 4 * rep, rep == 0 ? 63u : (unsigned)(REP_MASK));
#endif
        } else if (kind == 4 || kind == 7) {
            PHASE_CTX();
            const bool dn = kind == 7;
            pg8::Gemm g{dn ? WSP(bf16, WS_ACT) : WSP(bf16, WS_MIX), dn ? WSP(bf16, WS_WDN) + (size_t)l * DM * DFF : WSP(bf16, WS_WOUT) + (size_t)l * DM * DM, NTOK, DM, dn ? DFF : DM};
            pg8::StaticOrder S; S.init(NTOK, DM, C.G, C.bid, 64 * GMT);
            EpiF32<GMT> E{WSP(float, WS_Y), DM};
#ifndef SKIP_G24
            pg8::gemm_phase<EpiF32<GMT>, pg8::StaticOrder, true, true, GMT>(C.lds, g, S, E, C.tid);
#endif
        } else if (kind == 5 || kind == 8) {
            PHASE_CTX(); const float* mod = WSP(float, WS_MOD) + (size_t)l * 5 * 6144; const float* par = WSP(float, WS_PAR) + l * DM;
            if (kind == 5 && l == 0) rowwise<true, true>(C, true, mod + 2 * 1024, par + P_GPOSTMIX, par + P_GPREFFN, mod + 4 * 1024, mod + 3 * 1024);
            else if (kind == 5) rowwise<true, false>(C, true, mod + 2 * 1024, par + P_GPOSTMIX, par + P_GPREFFN, mod + 4 * 1024, mod + 3 * 1024);
            else           rowwise<true, false>(C, l + 1 < DEPTH_L, mod + 5 * 1024, par + P_GPOSTFFN, par + DM + P_GPREMIX, mod + 5 * 6144 + 1 * 1024, mod + 5 * 6144 + 0 * 1024);
        } else {
            PHASE_CTX();
            pg8::Gemm g{WSP(bf16, WS_H), WSP(bf16, WS_WGU) + (size_t)l * NGU * DM, NTOK, NGU, DM}; pg8::StaticOrder S; S.init(NTOK, NGU, C.G, C.bid, 64 * GMT3);
            EpiGLU<GMT3> E{WSP(bf16, WS_ACT)};
#ifndef SKIP_G3
            pg8::gemm_phase<EpiGLU<GMT3>, pg8::StaticOrder, true, true, GMT3>(C.lds, g, S, E, C.tid);
#endif
        }
#ifdef TIME_SEL
        GRID_BAR();
#else
        if (step + 1 < NSTEPS || rep + 1 < nrep) GRID_BAR();
#endif
        }
#ifdef TIME_SEL
        if (C0.bid == 0 && C0.tid == 0) { unsigned long long* T = (unsigned long long*)(C0.ws + WS_CTL) + 1024; const unsigned long long dt = __builtin_amdgcn_s_memrealtime() - t_start; T[kind] += dt; T[9] += dt; }
#endif
    }
#ifdef TIME_SEL
    {
        asm volatile("s_waitcnt vmcnt(0)" ::: "memory"); GRID_BAR();
        const unsigned long long ticks = __hip_atomic_load((unsigned long long*)(C0.ws + WS_CTL) + 1024 + TIME_SEL, __ATOMIC_RELAXED, __HIP_MEMORY_SCOPE_AGENT);
        float eps = (float)ticks * 0.01f / (float)(TIME_DIV);
#ifdef TIME_CONST
        eps = TIME_CONST;
#endif
        if (!diag_fresh) eps = 0.f;
        if (C0.bid == 0 && C0.tid == 0) __hip_atomic_store((unsigned*)(C0.ws + WS_PAR + 512 * 1024), 0x5eed1234u, __ATOMIC_RELAXED, __HIP_MEMORY_SCOPE_AGENT);
        for (int i = C0.bid * NTHR + C0.tid; i < NCTX * DM / 4; i += C0.G * NTHR) { f32x4 v = ((f32x4*)C0.out)[i]; v = v * (1.f + eps); ((f32x4*)C0.out)[i] = v; }
    }
#endif
}

extern "C" void kernel_launch(void* const* d_in, const int* in_sizes, int n_in, void* d_out, int out_size, void* d_ws, size_t ws_size, hipStream_t stream) {
    static int grid = 0;
    if (grid == 0) {
        if (n_in != 31 || (size_t)out_size != OUT_TOTAL || ws_size < WS_END) { fprintf(stderr, "kernel_launch: unexpected shapes: n_in %d out %d ws %zu (need %zu)\n", n_in, out_size, ws_size, (size_t)WS_END); grid = -1; return; }
        int dev = 0, cus = 0, per_cu = 0;
        if (hipGetDevice(&dev) != hipSuccess || hipDeviceGetAttribute(&cus, hipDeviceAttributeMultiprocessorCount, dev) != hipSuccess) { grid = -1; return; }
        if (hipFuncSetAttribute((const void*)fwd_kernel, hipFuncAttributeMaxDynamicSharedMemorySize, LDS_BYTES) != hipSuccess) { fprintf(stderr, "kernel_launch: hipFuncSetAttribute failed\n"); grid = -1; return; }
        if (hipOccupancyMaxActiveBlocksPerMultiprocessor(&per_cu, (const void*)fwd_kernel, NTHR, LDS_BYTES) != hipSuccess || per_cu < 1) { fprintf(stderr, "kernel_launch: occupancy query says %d blocks per CU\n", per_cu); (void)hipGetLastError(); grid = -1; return; }
        grid = cus;
    }
    if (grid < 0) return;
    if (hipMemsetAsync((char*)d_ws + WS_CTL, 0, CTL_ZERO_BYTES, stream) != hipSuccess) return;
    KArgs a{};
    for (int i = 0; i < 31; ++i) a.in[i] = (const float*)d_in[i];
    a.out = (float*)d_out; a.ws = (unsigned char*)d_ws;
    hipLaunchKernelGGL(fwd_kernel, dim3(grid), dim3(NTHR), LDS_BYTES, stream, a);
}
```

```cpp
#include <hip/hip_runtime.h>
#include <cstdio>
#include <cstdint>
namespace pg8 {
#define PG8_LAS __attribute__((address_space(3)))
typedef unsigned short bf16_t;
typedef short bf16x8 __attribute__((ext_vector_type(8)));
typedef float f32x4 __attribute__((ext_vector_type(4)));
typedef unsigned u32x4 __attribute__((ext_vector_type(4)));
constexpr int BM = 256, BK = 64, HALF = 128, HTB = HALF * BK * 2  , STAGE_BYTES = 8 * HTB, NXCD = 8, WGM = 8;

__host__ __device__ __forceinline__ int lds_byte(int r, int c) { const int st = (r >> 4) * 2 + (c >> 5), rr = r & 15, cc = c & 31, ob = rr * 64 + cc * 2; return st * 1024 + (ob ^ (((ob >> 9) & 1) << 5)); }
__host__ __device__ __forceinline__ void stage_rc(int b, int& R, int& C) { const int st = b / 1024, sb = b % 1024, swz = sb ^ (((sb >> 9) & 1) << 5); R = (st >> 1) * 16 + swz / 64; C = (st & 1) * 32 + (swz % 64) / 2; }
__host__ __device__ __forceinline__ int perm32(int rho) { const int n = rho >> 4, i = rho & 15; return 8 * (i >> 2) + 4 * n + (i & 3); }

struct Unit { int pm, pn; };
struct Gemm { const bf16_t* A; const bf16_t* Bt; int M, N, K; };

struct StaticOrder {
    int nM, nN, nwg, G, c;
    __host__ __device__ void init(int M, int N, int G_, int c_, int bm = BM) { nM = M / bm; nN = N / BM; nwg = nM * nN; G = G_; c = c_; }
    __host__ __device__ bool next(int i, Unit& u) const {
        const long L = (long)i * G + c; if (L >= nwg) return false;
        int wgid = (int)L; { const int q = nwg / NXCD, r = nwg % NXCD, xcd = wgid % NXCD, off = wgid / NXCD; wgid = (xcd < r ? xcd * (q + 1) : r * (q + 1) + (xcd - r) * q) + off; }
        const int nig = WGM * nN, gid = wgid / nig, fm = gid * WGM, gsz = (nM - fm) < WGM ? (nM - fm) : WGM;
        u.pm = fm + ((wgid % nig) % gsz); u.pn = (wgid % nig) / gsz; return true;
    }
    __device__ __forceinline__ void a_ready(const Unit&) const {}
    __device__ __forceinline__ void done(const Unit&) const {}
};

__device__ __forceinline__ unsigned cvt_pk_bf16(float lo, float hi) { unsigned r; asm volatile("v_cvt_pk_bf16_f32 %0, %1, %2" : "=v"(r) : "v"(lo), "v"(hi)); return r; }
typedef float f32x2 __attribute__((ext_vector_type(2)));
template <class Epi, class Sched, bool ALIGN_EPI = false, bool SP2 = false, int MT = 4  >
__device__ __forceinline__ void gemm_phase(PG8_LAS unsigned char* lds, const Gemm g, const Sched& S, const Epi& E, const int tid_in) {
    const int tid = tid_in, wid = __builtin_amdgcn_readfirstlane(tid >> 6), lane = tid & 63, wr = wid >> 2, wc = wid & 3, fr = lane & 15, fq = lane >> 4;
    const int K = g.K, nt = K / BK;
    unsigned voffA[2], voffB[2];
#pragma unroll
    for (int i = 0; i < 2; ++i) { int R, C; stage_rc(tid * 16 + i * 8192, R, C); const int Rb = Epi::PERM ? ((R & ~31) + perm32(R & 31)) : R;
        voffA[i] = (unsigned)(R * K + C) * 2u; voffB[i] = (unsigned)(Rb * K + C) * 2u; }
    const size_t kstep = (size_t)(BK * 2);
    const size_t hstepB = (size_t)HALF * K * 2, hstepA = (size_t)(32 * MT) * K * 2;
    const size_t tstepB = 2 * hstepB, tstepA = 2 * hstepA;
    const unsigned ldsw = (unsigned)wid * 1024u;
    const int aoff = lds_byte(wr * 16 * MT + fr, fq * 8), boff = lds_byte(wc * 32 + fr, fq * 8);
#define PG8_SA(b, h) (((b) * 2 + (h)) * HTB)
#define PG8_SB(b, h) ((4 + (b) * 2 + (h)) * HTB)
#define PG8_STAGE(bufoff, gbase, voff) do { _Pragma("unroll") for (int _i = 0; _i < 2; ++_i) \
        __builtin_amdgcn_global_load_lds((const unsigned*)((const char*)(gbase) + (voff)[_i]), (PG8_LAS unsigned*)(lds + (bufoff) + ldsw + _i * 8192), 16, 0, 0); } while (0)
#define PG8_LDA(dst, b, h) do { _Pragma("unroll") for (int m = 0; m < MT; ++m) _Pragma("unroll") for (int k = 0; k < 2; ++k) dst[m][k] = *(const PG8_LAS bf16x8*)(lds + PG8_SA(b, h) + aoff + m * 2048 + k * 1024); } while (0)
#define PG8_LDB(dst, b, h) do { _Pragma("unroll") for (int n = 0; n < 2; ++n) _Pragma("unroll") for (int k = 0; k < 2; ++k) dst[n][k] = *(const PG8_LAS bf16x8*)(lds + PG8_SB(b, h) + boff + n * 2048 + k * 1024); } while (0)
#define PG8_MMA(ai, bj, At, Bt) do { __builtin_amdgcn_s_setprio(1); _Pragma("unroll") for (int m = 0; m < MT; ++m) _Pragma("unroll") for (int n = 0; n < 2; ++n) _Pragma("unroll") for (int k = 0; k < 2; ++k) \
        acc[ai][bj][m][n] = __builtin_amdgcn_mfma_f32_16x16x32_bf16(Bt[n][k], At[m][k], acc[ai][bj][m][n], 0, 0, 0); __builtin_amdgcn_s_setprio(0); } while (0)
#define PG8_WAIT_V(n) asm volatile("s_waitcnt vmcnt(" #n ")" ::: "memory")
#define PG8_WAIT_L(n) asm volatile("s_waitcnt lgkmcnt(" #n ")" ::: "memory")
#define PG8_BAR __builtin_amdgcn_s_barrier()
#define PG8_SCHED __builtin_amdgcn_sched_barrier(0)
    Unit cur, nxt; int ui = 0;
    if (!S.next(0, cur)) return;
    f32x4 acc[2][2][MT][2];
#pragma unroll
    for (int a = 0; a < 2; ++a)
#pragma unroll
        for (int b = 0; b < 2; ++b)
#pragma unroll
            for (int m = 0; m < MT; ++m)
#pragma unroll
                for (int n = 0; n < 2; ++n) acc[a][b][m][n] = (f32x4){0.f, 0.f, 0.f, 0.f};
    bf16x8 At[MT][2], B0[2][2], B1[2][2];
    const char* cA = (const char*)g.A + (size_t)cur.pm * tstepA; const char* cB = (const char*)g.Bt + (size_t)cur.pn * tstepB;
    S.a_ready(cur);
    if constexpr (SP2) {
        PG8_STAGE(PG8_SB(0, 0), cB, voffB); PG8_STAGE(PG8_SB(0, 1), cB + hstepB, voffB); PG8_STAGE(PG8_SA(0, 0), cA, voffA); PG8_STAGE(PG8_SA(0, 1), cA + hstepA, voffA);
        if (wr == 1) PG8_BAR;
        PG8_WAIT_V(2); PG8_BAR;
        PG8_STAGE(PG8_SB(1, 0), cB + kstep, voffB); PG8_STAGE(PG8_SA(1, 0), cA + kstep, voffA); PG8_STAGE(PG8_SB(1, 1), cB + hstepB + kstep, voffB);
        PG8_WAIT_V(6); PG8_BAR;
    } else {
        PG8_STAGE(PG8_SB(0, 0), cB, voffB); PG8_STAGE(PG8_SA(0, 0), cA, voffA); PG8_STAGE(PG8_SB(0, 1), cB + hstepB, voffB); PG8_STAGE(PG8_SA(0, 1), cA + hstepA, voffA);
        if (wr == 1) PG8_BAR;
        PG8_WAIT_V(4); PG8_BAR;
        PG8_STAGE(PG8_SB(1, 0), cB + kstep, voffB); PG8_STAGE(PG8_SA(1, 0), cA + kstep, voffA); PG8_STAGE(PG8_SB(1, 1), cB + hstepB + kstep, voffB);
        PG8_WAIT_V(6); PG8_BAR;
    }
    for (;;) {
        const bool has_next = S.next(ui + 1, nxt);
        const char* nA = has_next ? (const char*)g.A + (size_t)nxt.pm * tstepA : cA; const char* nB = has_next ? (const char*)g.Bt + (size_t)nxt.pn * tstepB : cB;
        for (int t = 0; t < nt; t += 2) {
            const bool last = (t == nt - 2);
            const char* a1 = cA + (size_t)(t + 1) * kstep;
            const char* a2 = last ? nA : cA + (size_t)(t + 2) * kstep; const char* b2 = last ? nB : cB + (size_t)(t + 2) * kstep;
            const char* a3 = a2 + kstep; const char* b3 = b2 + kstep;
            if (last && has_next) S.a_ready(nxt);
            if constexpr (SP2) {
            PG8_LDB(B0, 0, 0); PG8_LDB(B1, 0, 1); PG8_SCHED; PG8_LDA(At, 0, 0); PG8_STAGE(PG8_SA(1, 1), a1 + hstepA, voffA);
            PG8_WAIT_V(8); PG8_WAIT_L(0); PG8_BAR; PG8_MMA(0, 0, At, B0); PG8_MMA(0, 1, At, B1); PG8_BAR; PG8_SCHED;
            PG8_LDA(At, 0, 1); PG8_STAGE(PG8_SB(0, 0), b2, voffB); PG8_STAGE(PG8_SB(0, 1), b2 + hstepB, voffB); PG8_STAGE(PG8_SA(0, 0), a2, voffA);
            PG8_WAIT_V(8); PG8_WAIT_L(0); PG8_BAR; PG8_MMA(1, 0, At, B0); PG8_MMA(1, 1, At, B1); PG8_BAR; PG8_SCHED;
            PG8_LDB(B0, 1, 0); PG8_LDB(B1, 1, 1); PG8_SCHED; PG8_LDA(At, 1, 0); PG8_STAGE(PG8_SA(0, 1), a2 + hstepA, voffA);
            PG8_WAIT_V(8); PG8_WAIT_L(0); PG8_BAR; PG8_MMA(0, 0, At, B0); PG8_MMA(0, 1, At, B1); PG8_BAR; PG8_SCHED;
            PG8_LDA(At, 1, 1); PG8_STAGE(PG8_SB(1, 0), b3, voffB); PG8_STAGE(PG8_SB(1, 1), b3 + hstepB, voffB); PG8_STAGE(PG8_SA(1, 0), a3, voffA);
            PG8_WAIT_V(8); PG8_WAIT_L(0); PG8_BAR; PG8_MMA(1, 0, At, B0); PG8_MMA(1, 1, At, B1); PG8_BAR; PG8_SCHED;
            } else {
            PG8_LDB(B0, 0, 0); PG8_SCHED; PG8_LDA(At, 0, 0); PG8_STAGE(PG8_SA(1, 1), a1 + hstepA, voffA);
            PG8_WAIT_L(8); PG8_BAR; PG8_WAIT_L(0); PG8_MMA(0, 0, At, B0); PG8_BAR; PG8_SCHED;
            PG8_LDB(B1, 0, 1); PG8_STAGE(PG8_SB(0, 0), b2, voffB);
            PG8_BAR; PG8_WAIT_L(0); PG8_MMA(0, 1, At, B1); PG8_BAR;
            PG8_LDA(At, 0, 1); PG8_STAGE(PG8_SA(0, 0), a2, voffA);
            PG8_BAR; PG8_WAIT_L(0); PG8_MMA(1, 0, At, B0); PG8_BAR; PG8_SCHED;
            PG8_STAGE(PG8_SB(0, 1), b2 + hstepB, voffB);
            PG8_WAIT_V(6); PG8_BAR; PG8_MMA(1, 1, At, B1); PG8_BAR;
            PG8_LDB(B0, 1, 0); PG8_SCHED; PG8_LDA(At, 1, 0); PG8_STAGE(PG8_SA(0, 1), a2 + hstepA, voffA);
            PG8_WAIT_L(8); PG8_BAR; PG8_WAIT_L(0); PG8_MMA(0, 0, At, B0); PG8_BAR; PG8_SCHED;
            PG8_LDB(B1, 1, 1); PG8_STAGE(PG8_SB(1, 0), b3, voffB);
            PG8_BAR; PG8_WAIT_L(0); PG8_MMA(0, 1, At, B1); PG8_BAR;
            PG8_LDA(At, 1, 1); PG8_STAGE(PG8_SA(1, 0), a3, voffA);
            PG8_BAR; PG8_WAIT_L(0); PG8_MMA(1, 0, At, B0); PG8_BAR; PG8_SCHED;
            PG8_STAGE(PG8_SB(1, 1), b3 + hstepB, voffB);
            PG8_WAIT_V(6); PG8_BAR; PG8_MMA(1, 1, At, B1); PG8_BAR;
            }
        }
        if constexpr (ALIGN_EPI) { if (wr == 0) PG8_BAR; }
        if constexpr (!Epi::AFTER_DRAIN) { E(acc, cur, wr, wc, fr, fq); S.done(cur); }
        if (!has_next) break;
#pragma unroll
        for (int a = 0; a < 2; ++a)
#pragma unroll
            for (int b = 0; b < 2; ++b)
#pragma unroll
                for (int m = 0; m < MT; ++m)
#pragma unroll
                    for (int n = 0; n < 2; ++n) acc[a][b][m][n] = (f32x4){0.f, 0.f, 0.f, 0.f};
        cur = nxt; cA = nA; cB = nB; ++ui;
        if constexpr (ALIGN_EPI) { if (wr == 1) PG8_BAR; }
    }
    PG8_WAIT_V(0);
    if constexpr (!ALIGN_EPI) { if (wr == 0) PG8_BAR; }
    PG8_BAR;
    if constexpr (Epi::AFTER_DRAIN) { E.fused(acc, cur, wr, wc, fr, fq, lds, wid, lane); S.done(cur); }
#undef PG8_SA
#undef PG8_SB
#undef PG8_STAGE
#undef PG8_LDA
#undef PG8_LDB
#undef PG8_MMA
#undef PG8_WAIT_V
#undef PG8_WAIT_L
#undef PG8_BAR
#undef PG8_SCHED
}
}
#define GAS __attribute__((address_space(1)))
#define LAS __attribute__((address_space(3)))
typedef unsigned short bf16;
typedef unsigned v4u __attribute__((ext_vector_type(4)));
typedef float f32x4 __attribute__((ext_vector_type(4)));
typedef short bf16x8 __attribute__((ext_vector_type(8)));
typedef GAS unsigned gu32;
typedef GAS unsigned long long gu64;
#define RLX_AGENT __ATOMIC_RELAXED, __HIP_MEMORY_SCOPE_AGENT
#define LDS_WAIT() asm volatile("s_waitcnt lgkmcnt(0)" ::: "memory")
#define VM_WAIT() asm volatile("s_waitcnt vmcnt(0)" ::: "memory")
__device__ __forceinline__ unsigned long long rt() { return __builtin_amdgcn_s_memrealtime(); }
__device__ __forceinline__ unsigned f2bf(float f) { unsigned u = __builtin_bit_cast(unsigned, f); return (u + 0x7fffu + ((u >> 16) & 1u)) >> 16; }
__device__ __forceinline__ unsigned pk2(float lo, float hi) { return f2bf(lo) | (f2bf(hi) << 16); }
#define XB_TMO      128
#define XB_XCNT(j)  (256  + 64 * (j))
#define XB_XSUB(j)  (1280 + 64 * (j))
#define XB_XGEN(j)  (2304 + 64 * (j))
#define XB_TOP      3328
#define XB_TOPGEN   3392
#define XCD_BAR_WORDS 3456
#define XB_SPIN_CAP (1u << 18)

__device__ __forceinline__ unsigned xb_ld(unsigned* p)              { return __hip_atomic_load(p, __ATOMIC_RELAXED, __HIP_MEMORY_SCOPE_AGENT); }
__device__ __forceinline__ unsigned xb_add(unsigned* p, unsigned v) { return __hip_atomic_fetch_add(p, v, __ATOMIC_RELAXED, __HIP_MEMORY_SCOPE_AGENT); }
__device__ __forceinline__ unsigned xb_xcc_id() { return (unsigned)__builtin_amdgcn_s_getreg((3 << 11) | 20) & 0xFu; }
#define XB_SPIN(cond, bar) do { unsigned _sp = 0; while (cond) { __builtin_amdgcn_s_sleep(1); \
    if ((++_sp & 255u) == 0u) { if (xb_ld(&(bar)[XB_TMO])) break; if (_sp > XB_SPIN_CAP) { atomicAdd(&(bar)[XB_TMO], 1u); break; } } } } while (0)

struct XcdBarrier {
    unsigned* bar; unsigned x;
    volatile LAS unsigned* st;
};

__device__ __forceinline__ XcdBarrier xcd_barrier_post(unsigned* bar, volatile LAS unsigned* st) {
    XcdBarrier b; b.bar = bar; b.x = xb_xcc_id(); b.st = st;
    if (threadIdx.x == 0) (void)xb_add(&bar[XB_XCNT(b.x)], 1u);
    return b;
}
__device__ __forceinline__ void xcd_barrier_complete(unsigned* bar, unsigned x, unsigned& nloc, unsigned& nx) {
    const unsigned G = gridDim.x * gridDim.y * gridDim.z;
    unsigned sum, cnt, mine, sp = 0u;
    for (;;) {
        sum = 0u; cnt = 0u; mine = 0u;
#pragma unroll
        for (unsigned j = 0; j < 16; ++j) { const unsigned c = xb_ld(&bar[XB_XCNT(j)]); sum += c; cnt += (c > 0u) ? 1u : 0u; mine = (j == x) ? c : mine; }
        if (sum == G) break;
        __builtin_amdgcn_s_sleep(1);
        if ((++sp & 255u) == 0u) { if (xb_ld(&bar[XB_TMO])) break; if (sp > XB_SPIN_CAP) { atomicAdd(&bar[XB_TMO], 1u); break; } }
    }
    nloc = mine > 0u ? mine : 1u; nx = cnt > 0u ? cnt : 1u;
}

__device__ __forceinline__ void xcd_barrier(const XcdBarrier& b) {
    asm volatile("s_waitcnt vmcnt(0)" ::: "memory");
    __syncthreads();
    if (threadIdx.x == 0) {
        unsigned* bar = b.bar;
        __builtin_amdgcn_s_waitcnt(0);
        unsigned nloc = b.st[0], nx = b.st[1];
        if (nloc == 0u) { xcd_barrier_complete(bar, b.x, nloc, nx); b.st[0] = nloc; b.st[1] = nx; }
        const unsigned old = xb_add(&bar[XB_XSUB(b.x)], 1u);
        const unsigned gen = old / nloc;
        if (old + 1u == (gen + 1u) * nloc) {
            __builtin_amdgcn_fence(__ATOMIC_RELEASE, "agent");
            asm volatile("s_waitcnt vmcnt(0)" ::: "memory");
            const unsigned og = xb_add(&bar[XB_TOP], 1u);
            const unsigned tg = og / nx;
            if (og + 1u == (tg + 1u) * nx) xb_add(&bar[XB_TOPGEN], 1u);
            else XB_SPIN(xb_ld(&bar[XB_TOPGEN]) == tg, bar);
            __builtin_amdgcn_fence(__ATOMIC_ACQUIRE, "agent");
            xb_add(&bar[XB_XGEN(b.x)], 1u);
            asm volatile("s_waitcnt vmcnt(0)" ::: "memory");
        } else {
            XB_SPIN(xb_ld(&bar[XB_XGEN(b.x)]) == gen, bar);
            __builtin_amdgcn_fence(__ATOMIC_ACQUIRE, "agent");
            asm volatile("s_waitcnt vmcnt(0)" ::: "memory");
        }
    }
    __syncthreads();
}

typedef float f32x16 __attribute__((ext_vector_type(16)));
typedef unsigned v2u __attribute__((ext_vector_type(2)));
typedef float f32x2v __attribute__((ext_vector_type(2)));
typedef short bf16x4 __attribute__((ext_vector_type(4)));

constexpr int NWAVES = 8, NTHR = 512;
constexpr int DM = 1024, NTOK = 12288, NCTX = 4096, DEPTH_L = 4, SEQC = 256, SEQL = 2048, PASTL = 256, SKL = 2304, DFF = 2816, NIN = 2048, NGU = 5632;
constexpr float EPS = 1e-6f;
constexpr float LOG2E = 1.4426950408889634f;
constexpr float QSCALE_A = 0.125f * LOG2E;
constexpr float QSCALE_B = 0.17677669529663687f * LOG2E;

constexpr size_t MiB = 1u << 20;
constexpr size_t WS_CTL = 0, CTL_ZERO_BYTES = 1 * MiB;
constexpr size_t WS_MOD = 1 * MiB;
constexpr size_t WS_WCT = WS_MOD + 512 * 1024;
constexpr size_t WS_WSB = WS_WCT + 128 * 1024;
constexpr size_t WS_ROPEA = WS_WSB + 512 * 1024;
constexpr size_t WS_ROPEB = WS_ROPEA + 8 * 1024;
constexpr size_t WS_LAM = WS_ROPEB + 4 * 1024;
constexpr size_t WS_PAR = 3 * MiB;
constexpr int P_GPREMIX = 0, P_GPOSTMIX = 4096, P_GPREFFN = 8192, P_GPOSTFFN = 12288, P_AQN = 16384, P_AKN = 16640, P_SUBLN = 16896, P_CSCALE = 17152, P_DVN = 18176, P_DBS = 19200, P_END = 21248;
constexpr size_t WS_WIN = 4 * MiB, WS_WOUT = 20 * MiB, WS_WGU = 28 * MiB, WS_WDN = 72 * MiB;
constexpr size_t WS_H = 94 * MiB, WS_QA = 118 * MiB, WS_QB = 124 * MiB, WS_KA = 130 * MiB, WS_VAT = 134 * MiB, WS_KB = 138 * MiB, WS_VBT = 146 * MiB;
constexpr size_t WS_CX = 154 * MiB, WS_U = 160 * MiB, WS_V = 166 * MiB, WS_MIX = 172 * MiB, WS_Y = 196 * MiB, WS_ACT = 244 * MiB;
constexpr size_t WS_KAC = 310 * MiB, WS_VATC = 311 * MiB, WS_KBC = 312 * MiB, WS_VBTC = 314 * MiB, WS_PARTIAL = 316 * MiB  , WS_END = 324 * MiB;
constexpr size_t KA_LAT = (size_t)16 * 2 * 256 * 64, KB_LAT = (size_t)16 * 4 * 256 * 64;
constexpr size_t OUT_AK = 12582912, OUT_AV = 14680064, OUT_BK = 16777216, OUT_BV = 20971520, OUT_TOTAL = 25165824;
constexpr int CW_BAR = 4096;
constexpr int CW_QUEUE = 16384;

constexpr int RING_BYTES = 131072, LDSCTL_OFF = RING_BYTES, MISC_OFF = LDSCTL_OFF + 320, LDS_BYTES = 147456;

struct KArgs { const float* in[31]; float* out; unsigned char* ws; };

#define CAS __attribute__((address_space(4)))
struct Ctx {
    const CAS unsigned long long* kp;
    float* out; unsigned char* ws;
    LAS unsigned char* lds; int tid, lane, wave, G, bid;
};
#define WSP(T, off) ((T*)(C.ws + (off)))
#define INP(i) ((const float*)C.kp[i])
#define REFRESH_KP() asm volatile("" : "+s"(C.kp))

__device__ __forceinline__ float wave_sum(float v) {
#pragma unroll
    for (int o = 1; o < 64; o <<= 1) v += __shfl_xor(v, o);
    return v;
}
__device__ __forceinline__ unsigned pkbf(float lo, float hi) { return pg8::cvt_pk_bf16(lo, hi); }
__device__ __forceinline__ v2u pk4(f32x4 v) { v2u r; r.x = pkbf(v[0], v[1]); r.y = pkbf(v[2], v[3]); return r; }
__device__ __forceinline__ float bf2f(unsigned short b) { return __builtin_bit_cast(float, (unsigned)b << 16); }
__device__ __forceinline__ float gelu_tanh(float x) {
    const float y = 0.7978845608028654f * (x + 0.044715f * x * x * x);
    const float e = __expf(2.f * y);
    const float t = 1.f - 2.f / (e + 1.f);
    return 0.5f * x * (1.f + t);
}
__device__ __forceinline__ float silu_f(float x) { return x / (1.f + __expf(-x)); }
__device__ __forceinline__ int cond_of_row(int row) { return row < NCTX ? 0 : 1 + ((row - NCTX) >> 11); }

__device__ __forceinline__ f32x2v rope_cs(int pos, int f) {
    const float inv = __builtin_amdgcn_exp2f(-(float)f * 0.83048202372184059f);
    const float ang = (float)pos * inv;
    const float k = __builtin_rintf(ang * 0.15915494309189535f);
    float r = __builtin_fmaf(-k, 6.2831854820251465f, ang); r = __builtin_fmaf(-k, -1.7484555e-7f, r);
    const float r2 = r * r; float sn = r, cs = 1.f, ts = r, tc = 1.f;
#pragma unroll 1
    for (int n = 1; n <= 10; ++n) { tc *= -r2 / (float)((2 * n - 1) * (2 * n)); ts *= -r2 / (float)((2 * n) * (2 * n + 1)); cs += tc; sn += ts; }
    return (f32x2v){cs, sn};
}
template <int KIND> __device__ __forceinline__ int rowmap(int n) {
    if (KIND == 1) { const int pn = n >> 8, wc = (n >> 6) & 3, bj = (n >> 5) & 1, q = n & 31; return (pn << 8) + (bj << 7) + (wc << 5) + q; }
    if (KIND == 2) return ((n >> 7) << 8) + (n & 127);
    if (KIND == 3) return ((n >> 7) << 8) + 128 + (n & 127);
    return n;
}
template <int KIND> __device__ __forceinline__ void transpose_item(const float* W, int K, int N, bf16* WT, LAS unsigned char* scr, int item, int lane) {
    const int nblk = N / 64, kb = item / nblk, nb = item % nblk, k0 = 64 * kb, n0 = 64 * nb;
    const int rg = lane >> 4, c4 = lane & 15;
    const float* src = W + (size_t)(k0 + 16 * rg) * N + n0 + 4 * c4;
    f32x4 v[16];
#pragma unroll
    for (int i = 0; i < 16; ++i) v[i] = *(const f32x4*)(src + (size_t)i * N);
    LAS bf16* T = (LAS bf16*)scr;
#pragma unroll
    for (int e = 0; e < 4; ++e) {
        v4u lo, hi;
        lo.x = pkbf(v[0][e], v[1][e]); lo.y = pkbf(v[2][e], v[3][e]); lo.z = pkbf(v[4][e], v[5][e]); lo.w = pkbf(v[6][e], v[7][e]);
        hi.x = pkbf(v[8][e], v[9][e]); hi.y = pkbf(v[10][e], v[11][e]); hi.z = pkbf(v[12][e], v[13][e]); hi.w = pkbf(v[14][e], v[15][e]);
        *(LAS v4u*)(T + (4 * c4 + e) * 72 + 16 * rg) = lo; *(LAS v4u*)(T + (4 * c4 + e) * 72 + 16 * rg + 8) = hi;
    }
    LDS_WAIT(); asm volatile("" ::: "memory");
#pragma unroll
    for (int j = 0; j < 8; ++j) { const int n = (lane >> 3) + 8 * j, ch = lane & 7;
        const v4u o = *(const LAS v4u*)(T + n * 72 + 8 * ch);
        *(v4u*)(WT + (size_t)rowmap<KIND>(n0 + n) * K + k0 + 8 * ch) = o; }
    LDS_WAIT(); asm volatile("" ::: "memory");
}

__device__ __forceinline__ void prep_caches(const Ctx& Cin) {
    Ctx C = Cin; REFRESH_KP();
    const int gt = C.bid * NTHR + C.tid, NGT = C.G * NTHR;
    const float* cak = INP(2); const float* cav = INP(3); const float* cbk = INP(4); const float* cbv = INP(5);
    bf16* KA = WSP(bf16, WS_KAC); bf16* VAT = WSP(bf16, WS_VATC); bf16* KB = WSP(bf16, WS_KBC); bf16* VBT = WSP(bf16, WS_VBTC);
    for (int i = gt; i < 4 * 4 * 256 * 128; i += NGT) {
        const int d = i & 63, kvh = (i >> 6) & 1, key = (i >> 7) & 255, l = (i >> 15) & 3, b = i >> 17;
        const size_t hb = (size_t)(l * 4 + b) * 2 + kvh;
        KA[(hb * 256 + key) * 64 + d] = (bf16)f2bf(cak[i]);
        VAT[(hb * 64 + d) * 256 + key] = (bf16)f2bf(cav[i]);
    }
    for (int i = gt; i < 4 * 4 * 256 * 256; i += NGT) {
        const int d = i & 63, h = (i >> 6) & 3, key = (i >> 8) & 255, l = (i >> 16) & 3, b = i >> 18;
        const size_t hb = (size_t)(l * 4 + b) * 4 + h;
        KB[(hb * 256 + key) * 64 + d] = (bf16)f2bf(cbk[i]);
        VBT[(hb * 64 + d) * 256 + key] = (bf16)f2bf(cbv[i]);
    }
}

__device__ __forceinline__ void phase0(const Ctx& Cin) {
    Ctx C = Cin;
    {
        LAS unsigned char* scr = C.lds + C.wave * 16384;
        const int gw = C.bid * NWAVES + C.wave, NGW = C.G * NWAVES;
        constexpr int I_MOD = DEPTH_L * 24 * 16;
        constexpr int I_IN = 16 * 32, I_OUT = 16 * 16, I_G = 16 * 44, I_D = 44 * 16, I_L = I_IN + I_OUT + 2 * I_G + I_D;
        for (int it = gw; it < I_MOD + DEPTH_L * I_L; it += NGW) {
            REFRESH_KP();
            if (it < I_MOD) {
                const int kc = it & 15, slab = (it >> 4) % 24, l = it / (16 * 24);
                LAS float* sc = (LAS float*)scr;
#pragma unroll
                for (int ci = 0; ci < 5; ++ci) { const float cv = ci == 0 ? INP(7)[64 * kc + C.lane] : INP(6)[(ci - 1) * 1024 + 64 * kc + C.lane]; sc[ci * 64 + C.lane] = silu_f(cv); }
                LDS_WAIT(); asm volatile("" ::: "memory");
                const float* W = INP(8) + ((size_t)l * DM + 64 * kc) * 6144 + 256 * slab + 4 * C.lane;
                f32x4 acc[5];
#pragma unroll
                for (int ci = 0; ci < 5; ++ci) acc[ci] = (f32x4){0.f, 0.f, 0.f, 0.f};
#pragma unroll 16
                for (int kk = 0; kk < 64; ++kk) { const f32x4 w = *(const f32x4*)(W + (size_t)kk * 6144);
#pragma unroll
                    for (int ci = 0; ci < 5; ++ci) acc[ci] += w * sc[ci * 64 + kk]; }
                float* part = WSP(float, WS_PARTIAL) + ((size_t)(l * 24 + slab) * 16 + kc) * 5 * 256 + 4 * C.lane;
#pragma unroll
                for (int ci = 0; ci < 5; ++ci) *(f32x4*)(part + ci * 256) = acc[ci];
                LDS_WAIT(); asm volatile("" ::: "memory");
                continue;
            }
            const int l = (it - I_MOD) / I_L; int r = (it - I_MOD) % I_L;
            if (r < I_IN) { transpose_item<1>(INP(14) + (size_t)l * DM * NIN, DM, NIN, WSP(bf16, WS_WIN) + (size_t)l * NIN * DM, scr, r, C.lane); continue; } r -= I_IN;
            if (r < I_OUT) { transpose_item<0>(INP(15) + (size_t)l * DM * DM, DM, DM, WSP(bf16, WS_WOUT) + (size_t)l * DM * DM, scr, r, C.lane); continue; } r -= I_OUT;
            if (r < I_G) { transpose_item<2>(INP(28) + (size_t)l * DM * DFF, DM, DFF, WSP(bf16, WS_WGU) + (size_t)l * NGU * DM, scr, r, C.lane); continue; } r -= I_G;
            if (r < I_G) { transpose_item<3>(INP(29) + (size_t)l * DM * DFF, DM, DFF, WSP(bf16, WS_WGU) + (size_t)l * NGU * DM, scr, r, C.lane); continue; } r -= I_G;
            transpose_item<0>(INP(30) + (size_t)l * DFF * DM, DFF, DM, WSP(bf16, WS_WDN) + (size_t)l * DM * DFF, scr, r, C.lane);
        }
    }
    {
        REFRESH_KP();
        const int gt = C.bid * NTHR + C.tid, NGT = C.G * NTHR;
        for (int i = gt; i < 4 * 4 * 64 * 64; i += NGT) { const int c = i & 63, e = (i >> 6) & 63, lg = i >> 12; WSP(bf16, WS_WCT)[i] = (bf16)f2bf(INP(23)[((size_t)lg * 64 + c) * 64 + e]); }
        for (int i = gt; i < 4 * 4 * 128 * 128; i += NGT) WSP(bf16, WS_WSB)[i] = (bf16)f2bf(INP(26)[i]);
        for (int i = gt; i < 64 * 16; i += NGT) { const int pos = i >> 4, f = i & 15; WSP(f32x2v, WS_ROPEA)[i] = rope_cs(pos, f); }
        for (int i = gt; i < 64 * 8; i += NGT) { const int pos = i >> 3, f = i & 7; WSP(f32x2v, WS_ROPEB)[i] = rope_cs(pos, 2 * f); }
        if (gt < 4) { const int l = gt; float s1 = 0.f, s2 = 0.f;
            for (int i = 0; i < 32; ++i) { s1 += INP(18)[l * 32 + i] * INP(19)[l * 32 + i]; s2 += INP(20)[l * 32 + i] * INP(21)[l * 32 + i]; }
            const float lam_init = 0.8f - 0.6f * expf(-0.3f * (float)l);
            WSP(float, WS_LAM)[l] = expf(s1) - expf(s2) + lam_init; }
    }
    {
        REFRESH_KP();
        const int gt = C.bid * NTHR + C.tid, NGT = C.G * NTHR; float* P = WSP(float, WS_PAR);
        for (int i = gt; i < 4096; i += NGT) { P[P_GPREMIX + i] = INP(10)[i]; P[P_GPOSTMIX + i] = INP(11)[i]; P[P_GPREFFN + i] = INP(12)[i]; P[P_GPOSTFFN + i] = INP(13)[i]; }
        for (int i = gt; i < 256; i += NGT) { P[P_AQN + i] = INP(16)[i]; P[P_AKN + i] = INP(17)[i]; P[P_SUBLN + i] = INP(22)[i]; }
        for (int i = gt; i < 1024; i += NGT) { P[P_CSCALE + i] = INP(24)[i]; P[P_DVN + i] = INP(25)[i]; }
        for (int i = gt; i < 2048; i += NGT) P[P_DBS + i] = INP(27)[i];
    }
    prep_caches(C);
}

template <bool HAS_Y, bool FROM_IN>
__device__ __forceinline__ void rowwise(const Ctx& C, const bool HAS_H, const float* gate_mod  , const float* gpost, const float* gpre, const float* scale_mod, const float* shift_mod) {
    const int gw = C.bid * NWAVES + C.wave, NGW = C.G * NWAVES;
    const float* Y = WSP(float, WS_Y); bf16* H = WSP(bf16, WS_H);
    for (int row = gw; row < NTOK; row += NGW) {
        const int ci = cond_of_row(row);
        const float* xin = FROM_IN ? (row < NCTX ? INP(0) + (size_t)row * DM : INP(1) + (size_t)(row - NCTX) * DM) : C.out + (size_t)row * DM;
        f32x4 x[4];
#pragma unroll
        for (int j = 0; j < 4; ++j) x[j] = ((const f32x4*)xin)[C.lane + 64 * j];
        if (HAS_Y) {
            f32x4 y[4]; float s = 0.f;
#pragma unroll
            for (int j = 0; j < 4; ++j) { y[j] = ((const f32x4*)(Y + (size_t)row * DM))[C.lane + 64 * j]; s += (y[j][0] * y[j][0] + y[j][1] * y[j][1]) + (y[j][2] * y[j][2] + y[j][3] * y[j][3]); }
            const float r = rsqrtf(wave_sum(s) * (1.f / DM) + EPS);
#pragma unroll
            for (int j = 0; j < 4; ++j) { const f32x4 g = ((const f32x4*)(gate_mod + (size_t)ci * 6144))[C.lane + 64 * j]; const f32x4 gp = ((const f32x4*)gpost)[C.lane + 64 * j];
                x[j] = x[j] + g * (y[j] * r * gp); ((f32x4*)(C.out + (size_t)row * DM))[C.lane + 64 * j] = x[j]; }
        }
        if (HAS_H) {
            float s = 0.f;
#pragma unroll
            for (int j = 0; j < 4; ++j) s += (x[j][0] * x[j][0] + x[j][1] * x[j][1]) + (x[j][2] * x[j][2] + x[j][3] * x[j][3]);
            const float r = rsqrtf(wave_sum(s) * (1.f / DM) + EPS);
#pragma unroll
            for (int j = 0; j < 4; ++j) { const f32x4 gp = ((const f32x4*)gpre)[C.lane + 64 * j]; const f32x4 sc = ((const f32x4*)(scale_mod + (size_t)ci * 6144))[C.lane + 64 * j]; const f32x4 sh = ((const f32x4*)(shift_mod + (size_t)ci * 6144))[C.lane + 64 * j];
                const f32x4 h = (x[j] * r * gp) * (sc + 1.f) + sh; ((v2u*)(H + (size_t)row * DM))[C.lane + 64 * j] = pk4(h); }
        }
    }
}

template <int MT> struct EpiF32 {
    static constexpr bool PERM = false, AFTER_DRAIN = false;
    float* Y; int ldc;
    __device__ __forceinline__ void operator()(const f32x4 (&acc)[2][2][MT][2], const pg8::Unit& u, int wr, int wc, int fr_in, int fq_in) const {
        int fr = fr_in, fq = fq_in; asm volatile("" : "+v"(fr), "+v"(fq));
#pragma unroll
        for (int ai = 0; ai < 2; ++ai)
#pragma unroll
            for (int m = 0; m < MT; ++m) { float* rowp = Y + (size_t)(u.pm * (64 * MT) + ai * (32 * MT) + wr * (16 * MT) + m * 16 + fr) * ldc + u.pn * 256 + wc * 32 + 4 * fq;
#pragma unroll
                for (int bj = 0; bj < 2; ++bj)
#pragma unroll
                    for (int n = 0; n < 2; ++n) *(f32x4*)(rowp + bj * 128 + n * 16) = acc[ai][bj][m][n]; }
    }
};
template <int MT> struct EpiGLU {
    static constexpr bool PERM = false, AFTER_DRAIN = false;
    bf16* O;
    __device__ __forceinline__ void operator()(const f32x4 (&acc)[2][2][MT][2], const pg8::Unit& u, int wr, int wc, int fr_in, int fq_in) const {
        int fr = fr_in, fq = fq_in; asm volatile("" : "+v"(fr), "+v"(fq));
#pragma unroll
        for (int ai = 0; ai < 2; ++ai)
#pragma unroll
            for (int m = 0; m < MT; ++m) { bf16* rowp = O + (size_t)(u.pm * (64 * MT) + ai * (32 * MT) + wr * (16 * MT) + m * 16 + fr) * DFF + u.pn * 128 + wc * 32 + 4 * fq;
#pragma unroll
                for (int n = 0; n < 2; ++n) { const f32x4 g = acc[ai][0][m][n], up = acc[ai][1][m][n]; f32x4 o;
#pragma unroll
                    for (int e = 0; e < 4; ++e) o[e] = silu_f(g[e]) * up[e];
                    *(v2u*)(rowp + n * 16) = pk4(o); } }
    }
};
template <int MT> struct EpiProj {
    static constexpr bool PERM = false, AFTER_DRAIN = false;
    unsigned char* ws; float* out; int layer;
    __device__ __forceinline__ void operator()(const f32x4 (&acc)[2][2][MT][2], const pg8::Unit& u, int wr, int wc, int fr_in, int fq_in) const {
        int fr = fr_in, fq = fq_in; asm volatile("" : "+v"(fr), "+v"(fq));
        const int pn = u.pn;
        const f32x2v* ropeA = (const f32x2v*)(ws + WS_ROPEA); const f32x2v* ropeB = (const f32x2v*)(ws + WS_ROPEB);
#pragma unroll
        for (int ai = 0; ai < 2; ++ai)
#pragma unroll
            for (int m = 0; m < MT; ++m) {
                const int rowg = u.pm * (64 * MT) + ai * (32 * MT) + wr * (16 * MT) + m * 16, row = rowg + fr;
                const bool lat = rowg >= NCTX;
                int b, s; if (lat) { const int rl = row - NCTX; b = rl >> 11; s = rl & 2047; } else { b = row >> 8; s = row & 255; }
                const int prow = s >> 6, pcol = s & 63;
                f32x4 v[2][2];
#pragma unroll
                for (int bj = 0; bj < 2; ++bj)
#pragma unroll
                    for (int n = 0; n < 2; ++n) v[bj][n] = acc[ai][bj][m][n];
                const int d0 = 4 * fq;
                if (pn == 0 || (pn == 1 && wc < 2)) {
                    float ss = 0.f;
#pragma unroll
                    for (int bj = 0; bj < 2; ++bj)
#pragma unroll
                        for (int n = 0; n < 2; ++n) ss += (v[bj][n][0] * v[bj][n][0] + v[bj][n][1] * v[bj][n][1]) + (v[bj][n][2] * v[bj][n][2] + v[bj][n][3] * v[bj][n][3]);
                    ss += __shfl_xor(ss, 16); ss += __shfl_xor(ss, 32);
                    const float r = rsqrtf(ss * (1.f / 64.f) + EPS);
                    const float* gn = (const float*)(ws + WS_PAR) + (pn == 0 ? P_AQN : P_AKN) + 64 * layer;
#pragma unroll
                    for (int bj = 0; bj < 2; ++bj)
#pragma unroll
                        for (int n = 0; n < 2; ++n) v[bj][n] = v[bj][n] * r * *(const f32x4*)(gn + 32 * bj + 16 * n + d0);
                    if (pn == 1 && !lat) {
                        float* o = out + OUT_AK + (((size_t)(b * 4 + layer) * 256 + s) * 128 + 64 * wc);
#pragma unroll
                        for (int bj = 0; bj < 2; ++bj)
#pragma unroll
                            for (int n = 0; n < 2; ++n) *(f32x4*)(o + 32 * bj + 16 * n + d0) = v[bj][n];
                    }
                    if (lat) {
#pragma unroll
                        for (int bj = 0; bj < 2; ++bj) { const int pos = bj == 0 ? prow : pcol;
#pragma unroll
                            for (int e = 0; e < 4; ++e) { const f32x2v cs = ropeA[pos * 16 + d0 + e]; const float x1 = v[bj][0][e], x2 = v[bj][1][e];
                                v[bj][0][e] = x1 * cs.x - x2 * cs.y; v[bj][1][e] = x2 * cs.x + x1 * cs.y; } }
                    }
                    if (pn == 0) {
                        bf16* o = (bf16*)(ws + WS_QA) + (size_t)row * 256 + 64 * wc;
#pragma unroll
                        for (int bj = 0; bj < 2; ++bj)
#pragma unroll
                            for (int n = 0; n < 2; ++n) *(v2u*)(o + 32 * bj + 16 * n + d0) = pk4(v[bj][n] * QSCALE_A);
                    } else {
                        bf16* o = (bf16*)(ws + WS_KA) + (lat ? KA_LAT + ((size_t)(b * 2 + wc) * SEQL + s) * 64 : ((size_t)(b * 2 + wc) * 256 + s) * 64);
#pragma unroll
                        for (int bj = 0; bj < 2; ++bj)
#pragma unroll
                            for (int n = 0; n < 2; ++n) *(v2u*)(o + 32 * bj + 16 * n + d0) = pk4(v[bj][n]);
                    }
                } else if (pn == 1) {
                    const int h = wc - 2;
                    if (!lat) { float* o = out + OUT_AV + (((size_t)(b * 4 + layer) * 256 + s) * 128 + 64 * h);
#pragma unroll
                        for (int bj = 0; bj < 2; ++bj)
#pragma unroll
                            for (int n = 0; n < 2; ++n) *(f32x4*)(o + 32 * bj + 16 * n + d0) = v[bj][n]; }
                    bf16* o = (bf16*)(ws + WS_VAT) + (lat ? KA_LAT + (size_t)(b * 2 + h) * 64 * SEQL + s : (size_t)(b * 2 + h) * 64 * 256 + s);
                    const int pitch = lat ? SEQL : 256;
#pragma unroll
                    for (int bj = 0; bj < 2; ++bj)
#pragma unroll
                        for (int n = 0; n < 2; ++n)
#pragma unroll
                            for (int e = 0; e < 4; ++e) o[(size_t)(32 * bj + 16 * n + d0 + e) * pitch] = (bf16)f2bf(v[bj][n][e]);
                } else if (pn == 2 || pn == 3) {
                    if (pn == 3 && !lat) { float* o = out + OUT_BK + (((size_t)(b * 4 + layer) * 256 + s) * 256 + 64 * wc);
#pragma unroll
                        for (int bj = 0; bj < 2; ++bj)
#pragma unroll
                            for (int n = 0; n < 2; ++n) *(f32x4*)(o + 32 * bj + 16 * n + d0) = v[bj][n]; }
                    if (lat) {
#pragma unroll
                        for (int bj = 0; bj < 2; ++bj)
#pragma unroll
                            for (int n = 0; n < 2; ++n) { const int pos = n == 0 ? prow : pcol;
#pragma unroll
                                for (int e = 0; e < 4; ++e) { const f32x2v cs = ropeB[pos * 8 + 4 * (fq & 1) + e]; const float mine = v[bj][n][e]; const float other = __shfl_xor(mine, 32);
                                    v[bj][n][e] = fq < 2 ? mine * cs.x - other * cs.y : mine * cs.x + other * cs.y; } }
                    }
                    if (pn == 2) { bf16* o = (bf16*)(ws + WS_QB) + (size_t)row * 256 + 64 * wc;
#pragma unroll
                        for (int bj = 0; bj < 2; ++bj)
#pragma unroll
                            for (int n = 0; n < 2; ++n) *(v2u*)(o + 32 * bj + 16 * n + d0) = pk4(v[bj][n] * QSCALE_B);
                    } else { bf16* o = (bf16*)(ws + WS_KB) + (lat ? KB_LAT + ((size_t)(b * 4 + wc) * SEQL + s) * 64 : ((size_t)(b * 4 + wc) * 256 + s) * 64);
#pragma unroll
                        for (int bj = 0; bj < 2; ++bj)
#pragma unroll
                            for (int n = 0; n < 2; ++n) *(v2u*)(o + 32 * bj + 16 * n + d0) = pk4(v[bj][n]); }
                } else if (pn == 4) {
                    if (!lat) { float* o = out + OUT_BV + (((size_t)(b * 4 + layer) * 256 + s) * 256 + 64 * wc);
#pragma unroll
                        for (int bj = 0; bj < 2; ++bj)
#pragma unroll
                            for (int n = 0; n < 2; ++n) *(f32x4*)(o + 32 * bj + 16 * n + d0) = v[bj][n]; }
                    bf16* o = (bf16*)(ws + WS_VBT) + (lat ? KB_LAT + (size_t)(b * 4 + wc) * 64 * SEQL + s : (size_t)(b * 4 + wc) * 64 * 256 + s);
                    const int pitch = lat ? SEQL : 256;
#pragma unroll
                    for (int bj = 0; bj < 2; ++bj)
#pragma unroll
                        for (int n = 0; n < 2; ++n)
#pragma unroll
                            for (int e = 0; e < 4; ++e) o[(size_t)(32 * bj + 16 * n + d0 + e) * pitch] = (bf16)f2bf(v[bj][n][e]);
                } else {
                    bf16* o = (bf16*)(ws + (pn == 5 ? WS_CX : pn == 6 ? WS_U : WS_V)) + (size_t)row * 256 + 64 * wc;
#pragma unroll
                    for (int bj = 0; bj < 2; ++bj)
#pragma unroll
                        for (int n = 0; n < 2; ++n) { f32x4 t = v[bj][n];
                            if (pn != 5) {
#pragma unroll
                                for (int e = 0; e < 4; ++e) t[e] = gelu_tanh(t[e]); }
                            *(v2u*)(o + 32 * bj + 16 * n + d0) = pk4(t); }
                }
            }
    }
};

constexpr int KS_STRIDE = 72, VS_STRIDE = 68, VS_OFF = 9216;
#define MFMA32(a, b, c) __builtin_amdgcn_mfma_f32_32x32x16_bf16(a, b, c, 0, 0, 0)
#define MFMA16(a, b, c) __builtin_amdgcn_mfma_f32_16x16x32_bf16(a, b, c, 0, 0, 0)

__device__ __forceinline__ bf16x8 pack8(const f32x16& p, int s) {
    v4u r; r.x = pkbf(p[8 * s + 0], p[8 * s + 1]); r.y = pkbf(p[8 * s + 2], p[8 * s + 3]); r.z = pkbf(p[8 * s + 4], p[8 * s + 5]); r.w = pkbf(p[8 * s + 6], p[8 * s + 7]);
    return __builtin_bit_cast(bf16x8, r);
}
__device__ __forceinline__ float max16(const f32x16& s) {
    float a = fmaxf(fmaxf(s[0], s[1]), fmaxf(s[2], s[3])), b = fmaxf(fmaxf(s[4], s[5]), fmaxf(s[6], s[7]));
    float c = fmaxf(fmaxf(s[8], s[9]), fmaxf(s[10], s[11])), d = fmaxf(fmaxf(s[12], s[13]), fmaxf(s[14], s[15]));
    return fmaxf(fmaxf(a, b), fmaxf(c, d));
}
constexpr float SUM_LIM = 4096.f;
template <bool REL>
__device__ __forceinline__ bool softmax_fast(f32x16& sa, f32x16& sb, float& l_run, float m_run) {
    float sum = 0.f;
#pragma unroll
    for (int i = 0; i < 16; ++i) { sa[i] = __builtin_amdgcn_exp2f(REL ? sa[i] : sa[i] - m_run); sb[i] = __builtin_amdgcn_exp2f(REL ? sb[i] : sb[i] - m_run); sum += sa[i] + sb[i]; }
    const bool ok = __all(sum <= SUM_LIM);
    if (ok) l_run += sum;
    return ok;
}
template <int NO, bool REL>
__device__ __forceinline__ void softmax_slow(f32x16& sa, f32x16& sb, float& m_run, f32x16& nm, float& l_run, f32x16 (&O)[NO], bool first) {
    float mx = fmaxf(max16(sa), max16(sb)); mx = fmaxf(mx, __shfl_xor(mx, 32));
    if (!REL) mx -= m_run;
    const float d = first ? mx : fmaxf(mx, 0.f);
    if (!REL) {
#pragma unroll
        for (int i = 0; i < 16; ++i) { sa[i] -= m_run; sb[i] -= m_run; } }
    m_run += d;
    if (REL) {
#pragma unroll
        for (int i = 0; i < 16; ++i) nm[i] = -m_run; }
    if (!first) { const float alpha = __builtin_amdgcn_exp2f(-d); l_run *= alpha;
#pragma unroll
        for (int k = 0; k < NO; ++k) O[k] = O[k] * alpha; }
    float sum = 0.f;
#pragma unroll
    for (int i = 0; i < 16; ++i) { sa[i] = __builtin_amdgcn_exp2f(sa[i] - d); sb[i] = __builtin_amdgcn_exp2f(sb[i] - d); sum += sa[i] + sb[i]; }
    l_run += sum;
}
constexpr int ATT_TILE = 8192, ATT_BUF = 2 * ATT_TILE;
template <int NK>
__device__ __forceinline__ void score_map(const LAS bf16* Ks, int r, int hh, int swz, int c0, const bf16x8* qf, const f32x16& nm, f32x16& sa, f32x16& sb) {
    sa = nm; sb = nm;
#pragma unroll
    for (int kk = 0; kk < NK; ++kk) {
        const int pc = ((c0 + 2 * kk + hh) ^ swz) * 8;
        const bf16x8 ka = *(const LAS bf16x8*)(Ks + r * 64 + pc), kb = *(const LAS bf16x8*)(Ks + (32 + r) * 64 + pc);
        sa = MFMA32(ka, qf[kk], sa); sb = MFMA32(kb, qf[kk], sb); }
}
__device__ __forceinline__ bf16x8 ld_vfrag(const LAS bf16* vrow, int s, int hh, int swz) {
    const v2u lo = *(const LAS v2u*)(vrow + ((2 * s) ^ swz) * 8 + 4 * hh), hi = *(const LAS v2u*)(vrow + ((2 * s + 1) ^ swz) * 8 + 4 * hh);
    return __builtin_bit_cast(bf16x8, (v4u){lo.x, lo.y, hi.x, hi.y});
}
template <bool DIFF>
__device__ __forceinline__ void attn_unit(const Ctx& C, const bf16* Q  , const bf16* K0, const bf16* VT0, int pitch0, int nt0, const bf16* K1, const bf16* VT1, int pitch1, int nt1,
                                          bf16* O  , float lam, float post_scale, const float* subln) {
    const int r = C.lane & 31, hh = C.lane >> 5, w = C.wave, swz = (r >> 1) & 7;
    const bf16* qrow = Q + (size_t)(32 * w + r) * 256;
    bf16x8 qf[4];
#pragma unroll
    for (int kk = 0; kk < 4; ++kk) qf[kk] = *(const bf16x8*)(qrow + 16 * kk + 8 * hh);
    f32x16 O0[2], O1[2], nm0;
#pragma unroll
    for (int i = 0; i < 16; ++i) { O0[0][i] = 0.f; O0[1][i] = 0.f; O1[0][i] = 0.f; O1[1][i] = 0.f; nm0[i] = 0.f; }
    float m0 = 0.f, l0 = 0.f, m1 = 0.f, l1 = 0.f;
    const int nt = nt0 + nt1;
    const int drow = 8 * w + (C.lane >> 3), dch = ((C.lane & 7) ^ ((drow >> 1) & 7)) * 8;
    const LAS unsigned char* ldsw = C.lds + w * 1024;
#define ATT_DMA(tl) do { const int tg = (tl); const bool s0 = tg < nt0; const int tt = s0 ? tg : tg - nt0; const bf16* Kp = s0 ? K0 : K1; const bf16* Vp = s0 ? VT0 : VT1; const int pitch = s0 ? pitch0 : pitch1; const int bo = (tg % 3) * ATT_BUF; \
        __builtin_amdgcn_global_load_lds((const unsigned*)(Kp + (size_t)(64 * tt + drow) * 64 + dch), (LAS unsigned*)(ldsw + bo), 16, 0, 0); \
        __builtin_amdgcn_global_load_lds((const unsigned*)(Vp + (size_t)drow * pitch + 64 * tt + dch), (LAS unsigned*)(ldsw + bo + ATT_TILE), 16, 0, 0); } while (0)
    __syncthreads();
    ATT_DMA(0);
    if (nt > 1) ATT_DMA(1);
#pragma unroll 1
    for (int t = 0; t < nt; ++t) {
        if (t + 1 < nt) asm volatile("s_waitcnt vmcnt(2)" ::: "memory"); else asm volatile("s_waitcnt vmcnt(0)" ::: "memory");
        __builtin_amdgcn_s_barrier();
        asm volatile("" ::: "memory");
        if (t + 2 < nt) ATT_DMA(t + 2);
        const LAS bf16* Ks = (const LAS bf16*)(C.lds + (t % 3) * ATT_BUF); const LAS bf16* Vs = (const LAS bf16*)(C.lds + (t % 3) * ATT_BUF + ATT_TILE);
        f32x16 sa, sb;
        if (!DIFF) {
            score_map<4>(Ks, r, hh, swz, 0, qf, nm0, sa, sb);
            if (t == 0 || !softmax_fast<true>(sa, sb, l0, 0.f)) { score_map<4>(Ks, r, hh, swz, 0, qf, nm0, sa, sb); softmax_slow<2, true>(sa, sb, m0, nm0, l0, O0, t == 0); }
#pragma unroll
            for (int s = 0; s < 4; ++s) {
                const bf16x8 pf = s < 2 ? pack8(sa, s) : pack8(sb, s - 2);
#pragma unroll
                for (int dt = 0; dt < 2; ++dt) O0[dt] = MFMA32(ld_vfrag(Vs + (32 * dt + r) * 64, s, hh, swz), pf, O0[dt]);
            }
        } else {
            score_map<2>(Ks, r, hh, swz, 0, qf, nm0, sa, sb);
            if (t == 0 || !softmax_fast<false>(sa, sb, l0, m0)) { score_map<2>(Ks, r, hh, swz, 0, qf, nm0, sa, sb); softmax_slow<2, false>(sa, sb, m0, nm0, l0, O0, t == 0); }
            bf16x8 pf0[4]; pf0[0] = pack8(sa, 0); pf0[1] = pack8(sa, 1); pf0[2] = pack8(sb, 0); pf0[3] = pack8(sb, 1);
            __builtin_amdgcn_sched_barrier(0);
            score_map<2>(Ks, r, hh, swz, 4, qf + 2, nm0, sa, sb);
            if (t == 0 || !softmax_fast<false>(sa, sb, l1, m1)) { score_map<2>(Ks, r, hh, swz, 4, qf + 2, nm0, sa, sb); softmax_slow<2, false>(sa, sb, m1, nm0, l1, O1, t == 0); }
#pragma unroll
            for (int s = 0; s < 4; ++s) {
                const bf16x8 pf1 = s < 2 ? pack8(sa, s) : pack8(sb, s - 2);
#pragma unroll
                for (int dt = 0; dt < 2; ++dt) { const bf16x8 vf = ld_vfrag(Vs + (32 * dt + r) * 64, s, hh, swz); O0[dt] = MFMA32(vf, pf0[s], O0[dt]); O1[dt] = MFMA32(vf, pf1, O1[dt]); }
            }
        }
    }
#undef ATT_DMA
    l0 += __shfl_xor(l0, 32); const float inv0 = 1.f / l0;
    bf16* orow = O + (size_t)(32 * w + r) * DM;
    if (!DIFF) {
#pragma unroll
        for (int dt = 0; dt < 2; ++dt)
#pragma unroll
            for (int g = 0; g < 4; ++g) { f32x4 o = {O0[dt][4 * g] * inv0, O0[dt][4 * g + 1] * inv0, O0[dt][4 * g + 2] * inv0, O0[dt][4 * g + 3] * inv0};
                *(v2u*)(orow + 32 * dt + 8 * g + 4 * hh) = pk4(o); }
    } else {
        l1 += __shfl_xor(l1, 32); const float inv1 = lam / l1;
        float ss = 0.f;
#pragma unroll
        for (int dt = 0; dt < 2; ++dt)
#pragma unroll
            for (int i = 0; i < 16; ++i) { const float o = O0[dt][i] * inv0 - O1[dt][i] * inv1; O0[dt][i] = o; ss += o * o; }
        ss += __shfl_xor(ss, 32);
        const float rr = rsqrtf(ss * (1.f / 64.f) + EPS) * post_scale;
#pragma unroll
        for (int dt = 0; dt < 2; ++dt)
#pragma unroll
            for (int g = 0; g < 4; ++g) { const f32x4 gn = *(const f32x4*)(subln + 32 * dt + 8 * g + 4 * hh);
                f32x4 o = {O0[dt][4 * g] * rr * gn[0], O0[dt][4 * g + 1] * rr * gn[1], O0[dt][4 * g + 2] * rr * gn[2], O0[dt][4 * g + 3] * rr * gn[3]};
                *(v2u*)(orow + 32 * dt + 8 * g + 4 * hh) = pk4(o); }
    }
}

__device__ __forceinline__ void pool_unit(const Ctx& C, int row0, int layer) {
    constexpr int XS = 264;
    LAS bf16* xs = (LAS bf16*)C.lds;
    LAS bf16* pl = (LAS bf16*)(C.lds + 80 * XS * 2);
    const bf16* CX = WSP(bf16, WS_CX);
    int S, bstart; if (row0 < NCTX) { S = SEQC; bstart = row0 & ~255; } else { S = SEQL; bstart = NCTX + ((row0 - NCTX) & ~2047); }
    const int t0 = row0 - bstart;
    __syncthreads();
    for (int i = C.tid; i < 80 * 32; i += NTHR) { const int rr = i >> 5, ch = i & 31; const int t = t0 - 8 + rr;
        v4u val = (v4u){0u, 0u, 0u, 0u}; if (t >= 0 && t < S) val = *(const v4u*)(CX + (size_t)(bstart + t) * 256 + 8 * ch);
        *(LAS v4u*)(xs + rr * XS + 8 * ch) = val; }
    __syncthreads();
    {
        const int cp = C.tid & 127, tq = C.tid >> 7, g = cp >> 5, half = 1 << g;
        for (int tt = 0; tt < 16; ++tt) { const int tl = tq * 16 + tt, t = t0 + tl;
            const int lo = max(t - half, 0), hi = min(t + half, S); float s0 = 0.f, s1 = 0.f;
            for (int k = lo; k < hi; ++k) { const unsigned pv = *(const LAS unsigned*)(xs + (k - t0 + 8) * XS + 2 * cp); s0 += bf2f((unsigned short)(pv & 0xffff)); s1 += bf2f((unsigned short)(pv >> 16)); }
            const unsigned cv = *(const LAS unsigned*)(xs + (tl + 8) * XS + 2 * cp); const float inv = 1.f / (float)(hi - lo);
            *(LAS unsigned*)(pl + tl * XS + 2 * cp) = pkbf(s0 * inv - bf2f((unsigned short)(cv & 0xffff)), s1 * inv - bf2f((unsigned short)(cv >> 16))); }
    }
    __syncthreads();
    {
        const int g = C.wave >> 1, mh = C.wave & 1, fr = C.lane & 15, fq = C.lane >> 4;
        const bf16* WCT = WSP(bf16, WS_WCT) + (size_t)(layer * 4 + g) * 4096;
        f32x4 acc[2][4];
#pragma unroll
        for (int mt = 0; mt < 2; ++mt)
#pragma unroll
            for (int nt = 0; nt < 4; ++nt) acc[mt][nt] = (f32x4){0.f, 0.f, 0.f, 0.f};
#pragma unroll
        for (int kk = 0; kk < 2; ++kk) {
            bf16x8 wf[4], xf[2];
#pragma unroll
            for (int nt = 0; nt < 4; ++nt) wf[nt] = *(const bf16x8*)(WCT + (16 * nt + fr) * 64 + 32 * kk + 8 * fq);
#pragma unroll
            for (int mt = 0; mt < 2; ++mt) xf[mt] = *(const LAS bf16x8*)(pl + (32 * mh + 16 * mt + fr) * XS + 64 * g + 32 * kk + 8 * fq);
#pragma unroll
            for (int mt = 0; mt < 2; ++mt)
#pragma unroll
                for (int nt = 0; nt < 4; ++nt) acc[mt][nt] = MFMA16(wf[nt], xf[mt], acc[mt][nt]);
        }
        const float* cs = WSP(float, WS_PAR) + P_CSCALE + layer * 256 + 64 * g;
        bf16* MIX = WSP(bf16, WS_MIX);
#pragma unroll
        for (int mt = 0; mt < 2; ++mt)
#pragma unroll
            for (int nt = 0; nt < 4; ++nt) { const f32x4 sc = *(const f32x4*)(cs + 16 * nt + 4 * fq);
                *(v2u*)(MIX + (size_t)(row0 + 32 * mh + 16 * mt + fr) * DM + 512 + 64 * g + 16 * nt + 4 * fq) = pk4(acc[mt][nt] * sc); }
    }
}

__device__ __forceinline__ void gate_unit(const Ctx& C, int row0, int layer) {
    constexpr int TS = 136;
    LAS bf16* vt = (LAS bf16*)C.lds;
    const bf16* V = WSP(bf16, WS_V); const bf16* U = WSP(bf16, WS_U);
    __syncthreads();
    {
        const int q = C.tid >> 2, qu = C.tid & 3;
        const bf16* src = V + (size_t)(row0 + q) * 256 + 64 * qu;
        v4u raw[8]; float ss = 0.f;
#pragma unroll
        for (int i = 0; i < 8; ++i) { raw[i] = *(const v4u*)(src + 8 * i);
#pragma unroll
            for (int j = 0; j < 4; ++j) { const float a = bf2f((unsigned short)(raw[i][j] & 0xffff)), b = bf2f((unsigned short)(raw[i][j] >> 16)); ss += a * a + b * b; } }
        ss += __shfl_xor(ss, 1); ss += __shfl_xor(ss, 2);
        const float r = rsqrtf(ss * (1.f / 256.f) + EPS);
        const float* gv = WSP(float, WS_PAR) + P_DVN + layer * 256 + 64 * qu;
#pragma unroll
        for (int i = 0; i < 8; ++i)
#pragma unroll
            for (int j = 0; j < 4; ++j) { const int c = 8 * i + 2 * j; const float a = bf2f((unsigned short)(raw[i][j] & 0xffff)) * r * gv[c], b = bf2f((unsigned short)(raw[i][j] >> 16)) * r * gv[c + 1];
                vt[(64 * qu + c) * TS + q] = (bf16)f2bf(a); vt[(64 * qu + c + 1) * TS + q] = (bf16)f2bf(b); }
    }
    __syncthreads();
    {
        const int g = C.wave >> 1, ph = C.wave & 1, fr = C.lane & 15, fq = C.lane >> 4;
        const bf16* WS_ = WSP(bf16, WS_WSB) + (size_t)(layer * 4 + g) * 16384;
        f32x4 acc[4][4];
#pragma unroll
        for (int pt = 0; pt < 4; ++pt)
#pragma unroll
            for (int ct = 0; ct < 4; ++ct) acc[pt][ct] = (f32x4){0.f, 0.f, 0.f, 0.f};
#pragma unroll
        for (int kk = 0; kk < 4; ++kk) {
            bf16x8 vf[4], wf[4];
#pragma unroll
            for (int ct = 0; ct < 4; ++ct) vf[ct] = *(const LAS bf16x8*)(vt + (64 * g + 16 * ct + fr) * TS + 32 * kk + 8 * fq);
#pragma unroll
            for (int pt = 0; pt < 4; ++pt) wf[pt] = *(const bf16x8*)(WS_ + (64 * ph + 16 * pt + fr) * 128 + 32 * kk + 8 * fq);
#pragma unroll
            for (int pt = 0; pt < 4; ++pt)
#pragma unroll
                for (int ct = 0; ct < 4; ++ct) acc[pt][ct] = MFMA16(vf[ct], wf[pt], acc[pt][ct]);
        }
        bf16* MIX = WSP(bf16, WS_MIX);
#pragma unroll
        for (int pt = 0; pt < 4; ++pt) { const int p = 64 * ph + 16 * pt + fr; const float bs = WSP(float, WS_PAR)[P_DBS + (layer * 4 + g) * 128 + p];
#pragma unroll
            for (int ct = 0; ct < 4; ++ct) { const v2u ur = *(const v2u*)(U + (size_t)(row0 + p) * 256 + 64 * g + 16 * ct + 4 * fq);
                f32x4 o; o[0] = bf2f((unsigned short)(ur.x & 0xffff)) * (acc[pt][ct][0] + bs); o[1] = bf2f((unsigned short)(ur.x >> 16)) * (acc[pt][ct][1] + bs);
                o[2] = bf2f((unsigned short)(ur.y & 0xffff)) * (acc[pt][ct][2] + bs); o[3] = bf2f((unsigned short)(ur.y >> 16)) * (acc[pt][ct][3] + bs);
                *(v2u*)(MIX + (size_t)(row0 + p) * DM + 768 + 64 * g + 16 * ct + 4 * fq) = pk4(o); } }
    }
}

constexpr int U_LATB = 128, U_LATA = 128, U_CTXB = 64, U_CTXA = 64, U_GATE = 96, U_POOL = 192, U_TOTAL = U_LATB + U_LATA + U_CTXB + U_CTXA + U_GATE + U_POOL;
__device__ __forceinline__ void mixer_phase(const Ctx& Cm, int qidx, unsigned mask) {
    const int layer = qidx & 3;
    volatile LAS unsigned* slot = (volatile LAS unsigned*)(Cm.lds + MISC_OFF + 64);
    gu32* head = (gu32*)(Cm.ws + WS_CTL) + CW_QUEUE + 64 * qidx;
    const float lam = ((const float*)(Cm.ws + WS_LAM))[layer];
    const float lam_init = 0.8f - 0.6f * expf(-0.3f * (float)layer);
    for (;;) {
        __syncthreads();
        if (Cm.tid == 0) slot[0] = __hip_atomic_fetch_add(head, 1u, RLX_AGENT);
        __syncthreads();
        int u = __builtin_amdgcn_readfirstlane((int)slot[0]);
        if (u >= U_TOTAL) break;
        { const int cls = u < U_LATB ? 0 : u < U_LATB + U_LATA ? 1 : u < U_LATB + U_LATA + U_CTXB ? 2 : u < U_LATB + U_LATA + U_CTXB + U_CTXA ? 3 : u < U_LATB + U_LATA + U_CTXB + U_CTXA + U_GATE ? 4 : 5; if (!((mask >> cls) & 1u)) continue; }
        Ctx C = Cm; asm volatile("" : "+s"(C.ws), "+v"(C.tid)); C.lane = C.tid & 63; C.wave = __builtin_amdgcn_readfirstlane(C.tid >> 6);
        const float* subln = WSP(float, WS_PAR) + P_SUBLN + layer * 64;
        bf16* MIX = WSP(bf16, WS_MIX);
        if (u < U_LATB + U_LATA + U_CTXB + U_CTXA) {
            bool diff, lat; int b, h, row0;
            if (u < U_LATB) { diff = true; lat = true; b = u >> 5; h = (u >> 3) & 3; row0 = NCTX + b * SEQL + 256 * (u & 7); }
            else if (u < U_LATB + U_LATA) { const int v = u - U_LATB; diff = false; lat = true; b = v >> 5; h = (v >> 3) & 3; row0 = NCTX + b * SEQL + 256 * (v & 7); }
            else if (u < U_LATB + U_LATA + U_CTXB) { const int v = u - U_LATB - U_LATA; diff = true; lat = false; b = v >> 2; h = v & 3; row0 = 256 * b; }
            else { const int v = u - U_LATB - U_LATA - U_CTXB; diff = false; lat = false; b = v >> 2; h = v & 3; row0 = 256 * b; }
            if (diff) {
#ifndef SKIP_ATT_B
                const size_t hn = (size_t)b * 4 + h, hc = (size_t)(layer * 4 + b) * 4 + h;
                const bf16* K0 = lat ? WSP(bf16, WS_KBC) + hc * 256 * 64 : WSP(bf16, WS_KB) + hn * 256 * 64;
                const bf16* V0 = lat ? WSP(bf16, WS_VBTC) + hc * 64 * 256 : WSP(bf16, WS_VBT) + hn * 64 * 256;
                attn_unit<true>(C, WSP(bf16, WS_QB) + (size_t)row0 * 256 + 64 * h, K0, V0, 256, 4,
                                WSP(bf16, WS_KB) + KB_LAT + hn * SEQL * 64, WSP(bf16, WS_VBT) + KB_LAT + hn * 64 * SEQL, SEQL, lat ? 32 : 0,
                                MIX + (size_t)row0 * DM + 256 + 64 * h, lam, 1.f - lam_init, subln);
#endif
            } else {
#ifndef SKIP_ATT_A
                const int kvh = h >> 1; const size_t hn = (size_t)b * 2 + kvh, hc = (size_t)(layer * 4 + b) * 2 + kvh;
                const bf16* K0 = lat ? WSP(bf16, WS_KAC) + hc * 256 * 64 : WSP(bf16, WS_KA) + hn * 256 * 64;
                const bf16* V0 = lat ? WSP(bf16, WS_VATC) + hc * 64 * 256 : WSP(bf16, WS_VAT) + hn * 64 * 256;
                attn_unit<false>(C, WSP(bf16, WS_QA) + (size_t)row0 * 256 + 64 * h, K0, V0, 256, 4,
                                 WSP(bf16, WS_KA) + KA_LAT + hn * SEQL * 64, WSP(bf16, WS_VAT) + KA_LAT + hn * 64 * SEQL, SEQL, lat ? 32 : 0,
                                 MIX + (size_t)row0 * DM + 64 * h, 0.f, 1.f, subln);
#endif
            }
            continue;
        }
        u -= U_LATB + U_LATA + U_CTXB;
        u -= U_CTXA;
#ifndef SKIP_GATE
        if (u < U_GATE) { gate_unit(C, 128 * u, layer); continue; }
#endif
        u -= U_GATE;
#ifndef SKIP_POOL
        if (u >= 0) pool_unit(C, 64 * u, layer);
#endif
    }
}

__global__ void __launch_bounds__(NTHR, 2) fwd_kernel(KArgs args) {
    extern __shared__ __attribute__((aligned(16))) unsigned char lds_raw[];
    Ctx C;
    C.kp = (const CAS unsigned long long*)__builtin_amdgcn_kernarg_segment_ptr();
    C.out = args.out; C.ws = args.ws;
    C.lds = (LAS unsigned char*)lds_raw; C.tid = threadIdx.x; C.lane = C.tid & 63; C.wave = __builtin_amdgcn_readfirstlane(C.tid >> 6); C.G = gridDim.x; C.bid = blockIdx.x;
    for (int u = C.tid; u < (LDS_BYTES - LDSCTL_OFF) / 4; u += NTHR) ((LAS unsigned*)(C.lds + LDSCTL_OFF))[u] = 0u;
    __syncthreads();
    XcdBarrier bar = xcd_barrier_post((unsigned*)(C.ws + WS_CTL) + CW_BAR, (volatile LAS unsigned*)(C.lds + MISC_OFF) + 8);
#define GRID_BAR() xcd_barrier(bar)

    const Ctx C0 = C;
#ifdef TIME_SEL
    const bool diag_fresh = __hip_atomic_load((unsigned*)(C0.ws + WS_PAR + 512 * 1024), __ATOMIC_RELAXED, __HIP_MEMORY_SCOPE_AGENT) != 0x5eed1234u;
#endif
#define PHASE_CTX() Ctx C = C0; asm volatile("" : "+s"(C.ws), "+s"(C.out), "+s"(C.G), "+s"(C.bid), "+v"(C.tid)); C.lane = C.tid & 63; C.wave = __builtin_amdgcn_readfirstlane(C.tid >> 6)
    constexpr int NSTEPS = 3 + 7 * DEPTH_L;
#ifndef GEMM_MT
#define GEMM_MT 3
#endif
#ifndef GEMM3_MT
#define GEMM3_MT 3
#endif
    constexpr int GMT = GEMM_MT, GMT3 = GEMM3_MT;
#ifndef REP_G1
#define REP_G1 1
#endif
#ifndef REP_MIX
#define REP_MIX 1
#endif
#ifndef REP_MASK
#define REP_MASK 63
#endif
#ifndef REP_G24
#define REP_G24 1
#endif
#ifndef REP_G3
#define REP_G3 1
#endif
#pragma unroll 1
    for (int step = 0; step < NSTEPS; ++step) {
        const int l = step < 3 ? 0 : (step - 3) / 7, kind = step == 0 ? 0 : step == 1 ? 9 : step == 2 ? 1 : 2 + (step - 3) % 7;
#ifdef TIME_SEL
        unsigned long long t_start = 0ull; if (C0.bid == 0 && C0.tid == 0) t_start = __builtin_amdgcn_s_memrealtime();
#endif
        const int nrep = kind == 2 ? REP_G1 : kind == 3 ? REP_MIX : (kind == 4 || kind == 7) ? REP_G24 : kind == 6 ? REP_G3 : 1;
#pragma unroll 1
        for (int rep = 0; rep < nrep; ++rep) {
        if (kind == 0) {
#ifndef SKIP_P0
            PHASE_CTX(); phase0(C);
#endif
        } else if (kind == 9) {
            PHASE_CTX(); REFRESH_KP();
            for (int i = C.bid * NTHR + C.tid; i < DEPTH_L * 5 * 1536; i += C.G * NTHR) {
                const int n4 = i % 1536, ci = (i / 1536) % 5, ll = i / (5 * 1536), slab = n4 >> 6, w4 = n4 & 63;
                f32x4 sum = *(const f32x4*)(INP(9) + (size_t)ll * 6144 + 4 * n4);
                const float* p0 = WSP(float, WS_PARTIAL) + (size_t)(ll * 24 + slab) * 16 * 5 * 256 + ci * 256 + 4 * w4;
#pragma unroll
                for (int k = 0; k < 16; ++k) sum += *(const f32x4*)(p0 + (size_t)k * 5 * 256);
                *(f32x4*)(WSP(float, WS_MOD) + ((size_t)ll * 5 + ci) * 6144 + 4 * n4) = sum;
            }
        } else if (kind == 1) {
            PHASE_CTX(); const float* mod = WSP(float, WS_MOD);
            rowwise<false, true>(C, true, nullptr, nullptr, WSP(float, WS_PAR) + P_GPREMIX, mod + 1 * 1024, mod + 0 * 1024);
        } else if (kind == 2) {
            PHASE_CTX();
            pg8::Gemm g{WSP(bf16, WS_H), WSP(bf16, WS_WIN) + (size_t)l * NIN * DM, NTOK, NIN, DM}; pg8::StaticOrder S; S.init(NTOK, NIN, C.G, C.bid, 64 * GMT);
            EpiProj<GMT> E{C.ws, C.out, l};
#ifndef SKIP_G1
            pg8::gemm_phase<EpiProj<GMT>, pg8::StaticOrder, true, true, GMT>(C.lds, g, S, E, C.tid);
#endif
        } else if (kind == 3) {
#ifndef SKIP_MIX
            PHASE_CTX(); mixer_phase(C, l + 4 * rep, rep == 0 ? 63u : (unsigned)(REP_MASK));
#endif
        } else if (kind == 4 || kind == 7) {
            PHASE_CTX();
            const bool dn = kind == 7;
            pg8::Gemm g{dn ? WSP(bf16, WS_ACT) : WSP(bf16, WS_MIX), dn ? WSP(bf16, WS_WDN) + (size_t)l * DM * DFF : WSP(bf16, WS_WOUT) + (size_t)l * DM * DM, NTOK, DM, dn ? DFF : DM};
            pg8::StaticOrder S; S.init(NTOK, DM, C.G, C.bid, 64 * GMT);
            EpiF32<GMT> E{WSP(float, WS_Y), DM};
#ifndef SKIP_G24
            pg8::gemm_phase<EpiF32<GMT>, pg8::StaticOrder, true, true, GMT>(C.lds, g, S, E, C.tid);
#endif
        } else if (kind == 5 || kind == 8) {
            PHASE_CTX(); const float* mod = WSP(float, WS_MOD) + (size_t)l * 5 * 6144; const float* par = WSP(float, WS_PAR) + l * DM;
            if (kind == 5 && l == 0) rowwise<true, true>(C, true, mod + 2 * 1024, par + P_GPOSTMIX, par + P_GPREFFN, mod + 4 * 1024, mod + 3 * 1024);
            else if (kind == 5) rowwise<true, false>(C, true, mod + 2 * 1024, par + P_GPOSTMIX, par + P_GPREFFN, mod + 4 * 1024, mod + 3 * 1024);
            else           rowwise<true, false>(C, l + 1 < DEPTH_L, mod + 5 * 1024, par + P_GPOSTFFN, par + DM + P_GPREMIX, mod + 5 * 6144 + 1 * 1024, mod + 5 * 6144 + 0 * 1024);
        } else {
            PHASE_CTX();
            pg8::Gemm g{WSP(bf16, WS_H), WSP(bf16, WS_WGU) + (size_t)l * NGU * DM, NTOK, NGU, DM}; pg8::StaticOrder S; S.init(NTOK, NGU, C.G, C.bid, 64 * GMT3);
            EpiGLU<GMT3> E{WSP(bf16, WS_ACT)};
#ifndef SKIP_G3
            pg8::gemm_phase<EpiGLU<GMT3>, pg8::StaticOrder, true, true, GMT3>(C.lds, g, S, E, C.tid);
#endif
        }
#ifdef TIME_SEL
        GRID_BAR();
#else
        if (step + 1 < NSTEPS || rep + 1 < nrep) GRID_BAR();
#endif
        }
#ifdef TIME_SEL
        if (C0.bid == 0 && C0.tid == 0) { unsigned long long* T = (unsigned long long*)(C0.ws + WS_CTL) + 1024; const unsigned long long dt = __builtin_amdgcn_s_memrealtime() - t_start; T[kind] += dt; T[9] += dt; }
#endif
    }
#ifdef TIME_SEL
    {
        asm volatile("s_waitcnt vmcnt(0)" ::: "memory"); GRID_BAR();
        const unsigned long long ticks = __hip_atomic_load((unsigned long long*)(C0.ws + WS_CTL) + 1024 + TIME_SEL, __ATOMIC_RELAXED, __HIP_MEMORY_SCOPE_AGENT);
        float eps = (float)ticks * 0.01f / (float)(TIME_DIV);
#ifdef TIME_CONST
        eps = TIME_CONST;
#endif
        if (!diag_fresh) eps = 0.f;
        if (C0.bid == 0 && C0.tid == 0) __hip_atomic_store((unsigned*)(C0.ws + WS_PAR + 512 * 1024), 0x5eed1234u, __ATOMIC_RELAXED, __HIP_MEMORY_SCOPE_AGENT);
        for (int i = C0.bid * NTHR + C0.tid; i < NCTX * DM / 4; i += C0.G * NTHR) { f32x4 v = ((f32x4*)C0.out)[i]; v = v * (1.f + eps); ((f32x4*)C0.out)[i] = v; }
    }
#endif
}

extern "C" void kernel_launch(void* const* d_in, const int* in_sizes, int n_in, void* d_out, int out_size, void* d_ws, size_t ws_size, hipStream_t stream) {
    static int grid = 0;
    if (grid == 0) {
        if (n_in != 31 || (size_t)out_size != OUT_TOTAL || ws_size < WS_END) { fprintf(stderr, "kernel_launch: unexpected shapes: n_in %d out %d ws %zu (need %zu)\n", n_in, out_size, ws_size, (size_t)WS_END); grid = -1; return; }
        int dev = 0, cus = 0, per_cu = 0;
        if (hipGetDevice(&dev) != hipSuccess || hipDeviceGetAttribute(&cus, hipDeviceAttributeMultiprocessorCount, dev) != hipSuccess) { grid = -1; return; }
        if (hipFuncSetAttribute((const void*)fwd_kernel, hipFuncAttributeMaxDynamicSharedMemorySize, LDS_BYTES) != hipSuccess) { fprintf(stderr, "kernel_launch: hipFuncSetAttribute failed\n"); grid = -1; return; }
        if (hipOccupancyMaxActiveBlocksPerMultiprocessor(&per_cu, (const void*)fwd_kernel, NTHR, LDS_BYTES) != hipSuccess || per_cu < 1) { fprintf(stderr, "kernel_launch: occupancy query says %d blocks per CU\n", per_cu); (void)hipGetLastError(); grid = -1; return; }
        grid = cus;
    }
    if (grid < 0) return;
    if (hipMemsetAsync((char*)d_ws + WS_CTL, 0, CTL_ZERO_BYTES, stream) != hipSuccess) return;
    KArgs a{};
    for (int i = 0; i < 31; ++i) a.in[i] = (const float*)d_in[i];
    a.out = (float*)d_out; a.ws = (unsigned char*)d_ws;
    hipLaunchKernelGGL(fwd_kernel, dim3(grid), dim3(NTHR), LDS_BYTES, stream, a);
}
```

```cpp
#include <hip/hip_runtime.h>
#include <cstdio>
#include <cstdint>
namespace pg8 {
#define PG8_LAS __attribute__((address_space(3)))
typedef unsigned short bf16_t;
typedef short bf16x8 __attribute__((ext_vector_type(8)));
typedef float f32x4 __attribute__((ext_vector_type(4)));
typedef unsigned u32x4 __attribute__((ext_vector_type(4)));
constexpr int BM = 256, BK = 64, HALF = 128, HTB = HALF * BK * 2  , STAGE_BYTES = 8 * HTB, NXCD = 8, WGM = 8;

__host__ __device__ __forceinline__ int lds_byte(int r, int c) { const int st = (r >> 4) * 2 + (c >> 5), rr = r & 15, cc = c & 31, ob = rr * 64 + cc * 2; return st * 1024 + (ob ^ (((ob >> 9) & 1) << 5)); }
__host__ __device__ __forceinline__ void stage_rc(int b, int& R, int& C) { const int st = b / 1024, sb = b % 1024, swz = sb ^ (((sb >> 9) & 1) << 5); R = (st >> 1) * 16 + swz / 64; C = (st & 1) * 32 + (swz % 64) / 2; }
__host__ __device__ __forceinline__ int perm32(int rho) { const int n = rho >> 4, i = rho & 15; return 8 * (i >> 2) + 4 * n + (i & 3); }

struct Unit { int pm, pn; };
struct Gemm { const bf16_t* A; const bf16_t* Bt; int M, N, K; };

struct StaticOrder {
    int nM, nN, nwg, G, c;
    __host__ __device__ void init(int M, int N, int G_, int c_, int bm = BM) { nM = M / bm; nN = N / BM; nwg = nM * nN; G = G_; c = c_; }
    __host__ __device__ bool next(int i, Unit& u) const {
        const long L = (long)i * G + c; if (L >= nwg) return false;
        int wgid = (int)L; { const int q = nwg / NXCD, r = nwg % NXCD, xcd = wgid % NXCD, off = wgid / NXCD; wgid = (xcd < r ? xcd * (q + 1) : r * (q + 1) + (xcd - r) * q) + off; }
        const int nig = WGM * nN, gid = wgid / nig, fm = gid * WGM, gsz = (nM - fm) < WGM ? (nM - fm) : WGM;
        u.pm = fm + ((wgid % nig) % gsz); u.pn = (wgid % nig) / gsz; return true;
    }
    __device__ __forceinline__ void a_ready(const Unit&) const {}
    __device__ __forceinline__ void done(const Unit&) const {}
};

__device__ __forceinline__ unsigned cvt_pk_bf16(float lo, float hi) { unsigned r; asm volatile("v_cvt_pk_bf16_f32 %0, %1, %2" : "=v"(r) : "v"(lo), "v"(hi)); return r; }
typedef float f32x2 __attribute__((ext_vector_type(2)));
template <class Epi, class Sched, bool ALIGN_EPI = false, bool SP2 = false, int MT = 4  >
__device__ __forceinline__ void gemm_phase(PG8_LAS unsigned char* lds, const Gemm g, const Sched& S, const Epi& E, const int tid_in) {
    const int tid = tid_in, wid = __builtin_amdgcn_readfirstlane(tid >> 6), lane = tid & 63, wr = wid >> 2, wc = wid & 3, fr = lane & 15, fq = lane >> 4;
    const int K = g.K, nt = K / BK;
    unsigned voffA[2], voffB[2];
#pragma unroll
    for (int i = 0; i < 2; ++i) { int R, C; stage_rc(tid * 16 + i * 8192, R, C); const int Rb = Epi::PERM ? ((R & ~31) + perm32(R & 31)) : R;
        voffA[i] = (unsigned)(R * K + C) * 2u; voffB[i] = (unsigned)(Rb * K + C) * 2u; }
    const size_t kstep = (size_t)(BK * 2);
    const size_t hstepB = (size_t)HALF * K * 2, hstepA = (size_t)(32 * MT) * K * 2;
    const size_t tstepB = 2 * hstepB, tstepA = 2 * hstepA;
    const unsigned ldsw = (unsigned)wid * 1024u;
    const int aoff = lds_byte(wr * 16 * MT + fr, fq * 8), boff = lds_byte(wc * 32 + fr, fq * 8);
#define PG8_SA(b, h) (((b) * 2 + (h)) * HTB)
#define PG8_SB(b, h) ((4 + (b) * 2 + (h)) * HTB)
#define PG8_STAGE(bufoff, gbase, voff) do { _Pragma("unroll") for (int _i = 0; _i < 2; ++_i) \
        __builtin_amdgcn_global_load_lds((const unsigned*)((const char*)(gbase) + (voff)[_i]), (PG8_LAS unsigned*)(lds + (bufoff) + ldsw + _i * 8192), 16, 0, 0); } while (0)
#define PG8_LDA(dst, b, h) do { _Pragma("unroll") for (int m = 0; m < MT; ++m) _Pragma("unroll") for (int k = 0; k < 2; ++k) dst[m][k] = *(const PG8_LAS bf16x8*)(lds + PG8_SA(b, h) + aoff + m * 2048 + k * 1024); } while (0)
#define PG8_LDB(dst, b, h) do { _Pragma("unroll") for (int n = 0; n < 2; ++n) _Pragma("unroll") for (int k = 0; k < 2; ++k) dst[n][k] = *(const PG8_LAS bf16x8*)(lds + PG8_SB(b, h) + boff + n * 2048 + k * 1024); } while (0)
#define PG8_MMA(ai, bj, At, Bt) do { __builtin_amdgcn_s_setprio(1); _Pragma("unroll") for (int m = 0; m < MT; ++m) _Pragma("unroll") for (int n = 0; n < 2; ++n) _Pragma("unroll") for (int k = 0; k < 2; ++k) \
        acc[ai][bj][m][n] = __builtin_amdgcn_mfma_f32_16x16x32_bf16(Bt[n][k], At[m][k], acc[ai][bj][m][n], 0, 0, 0); __builtin_amdgcn_s_setprio(0); } while (0)
#define PG8_WAIT_V(n) asm volatile("s_waitcnt vmcnt(" #n ")" ::: "memory")
#define PG8_WAIT_L(n) asm volatile("s_waitcnt lgkmcnt(" #n ")" ::: "memory")
#define PG8_BAR __builtin_amdgcn_s_barrier()
#define PG8_SCHED __builtin_amdgcn_sched_barrier(0)
    Unit cur, nxt; int ui = 0;
    if (!S.next(0, cur)) return;
    f32x4 acc[2][2][MT][2];
#pragma unroll
    for (int a = 0; a < 2; ++a)
#pragma unroll
        for (int b = 0; b < 2; ++b)
#pragma unroll
            for (int m = 0; m < MT; ++m)
#pragma unroll
                for (int n = 0; n < 2; ++n) acc[a][b][m][n] = (f32x4){0.f, 0.f, 0.f, 0.f};
    bf16x8 At[MT][2], B0[2][2], B1[2][2];
    const char* cA = (const char*)g.A + (size_t)cur.pm * tstepA; const char* cB = (const char*)g.Bt + (size_t)cur.pn * tstepB;
    S.a_ready(cur);
    if constexpr (SP2) {
        PG8_STAGE(PG8_SB(0, 0), cB, voffB); PG8_STAGE(PG8_SB(0, 1), cB + hstepB, voffB); PG8_STAGE(PG8_SA(0, 0), cA, voffA); PG8_STAGE(PG8_SA(0, 1), cA + hstepA, voffA);
        if (wr == 1) PG8_BAR;
        PG8_WAIT_V(2); PG8_BAR;
        PG8_STAGE(PG8_SB(1, 0), cB + kstep, voffB); PG8_STAGE(PG8_SA(1, 0), cA + kstep, voffA); PG8_STAGE(PG8_SB(1, 1), cB + hstepB + kstep, voffB);
        PG8_WAIT_V(6); PG8_BAR;
    } else {
        PG8_STAGE(PG8_SB(0, 0), cB, voffB); PG8_STAGE(PG8_SA(0, 0), cA, voffA); PG8_STAGE(PG8_SB(0, 1), cB + hstepB, voffB); PG8_STAGE(PG8_SA(0, 1), cA + hstepA, voffA);
        if (wr == 1) PG8_BAR;
        PG8_WAIT_V(4); PG8_BAR;
        PG8_STAGE(PG8_SB(1, 0), cB + kstep, voffB); PG8_STAGE(PG8_SA(1, 0), cA + kstep, voffA); PG8_STAGE(PG8_SB(1, 1), cB + hstepB + kstep, voffB);
        PG8_WAIT_V(6); PG8_BAR;
    }
    for (;;) {
        const bool has_next = S.next(ui + 1, nxt);
        const char* nA = has_next ? (const char*)g.A + (size_t)nxt.pm * tstepA : cA; const char* nB = has_next ? (const char*)g.Bt + (size_t)nxt.pn * tstepB : cB;
        for (int t = 0; t < nt; t += 2) {
            const bool last = (t == nt - 2);
            const char* a1 = cA + (size_t)(t + 1) * kstep;
            const char* a2 = last ? nA : cA + (size_t)(t + 2) * kstep; const char* b2 = last ? nB : cB + (size_t)(t + 2) * kstep;
            const char* a3 = a2 + kstep; const char* b3 = b2 + kstep;
            if (last && has_next) S.a_ready(nxt);
            if constexpr (SP2) {
            PG8_LDB(B0, 0, 0); PG8_LDB(B1, 0, 1); PG8_SCHED; PG8_LDA(At, 0, 0); PG8_STAGE(PG8_SA(1, 1), a1 + hstepA, voffA);
            PG8_WAIT_V(8); PG8_WAIT_L(0); PG8_BAR; PG8_MMA(0, 0, At, B0); PG8_MMA(0, 1, At, B1); PG8_BAR; PG8_SCHED;
            PG8_LDA(At, 0, 1); PG8_STAGE(PG8_SB(0, 0), b2, voffB); PG8_STAGE(PG8_SB(0, 1), b2 + hstepB, voffB); PG8_STAGE(PG8_SA(0, 0), a2, voffA);
            PG8_WAIT_V(8); PG8_WAIT_L(0); PG8_BAR; PG8_MMA(1, 0, At, B0); PG8_MMA(1, 1, At, B1); PG8_BAR; PG8_SCHED;
            PG8_LDB(B0, 1, 0); PG8_LDB(B1, 1, 1); PG8_SCHED; PG8_LDA(At, 1, 0); PG8_STAGE(PG8_SA(0, 1), a2 + hstepA, voffA);
            PG8_WAIT_V(8); PG8_WAIT_L(0); PG8_BAR; PG8_MMA(0, 0, At, B0); PG8_MMA(0, 1, At, B1); PG8_BAR; PG8_SCHED;
            PG8_LDA(At, 1, 1); PG8_STAGE(PG8_SB(1, 0), b3, voffB); PG8_STAGE(PG8_SB(1, 1), b3 + hstepB, voffB); PG8_STAGE(PG8_SA(1, 0), a3, voffA);
            PG8_WAIT_V(8); PG8_WAIT_L(0); PG8_BAR; PG8_MMA(1, 0, At, B0); PG8_MMA(1, 1, At, B1); PG8_BAR; PG8_SCHED;
            } else {
            PG8_LDB(B0, 0, 0); PG8_SCHED; PG8_LDA(At, 0, 0); PG8_STAGE(PG8_SA(1, 1), a1 + hstepA, voffA);
            PG8_WAIT_L(8); PG8_BAR; PG8_WAIT_L(0); PG8_MMA(0, 0, At, B0); PG8_BAR; PG8_SCHED;
            PG8_LDB(B1, 0, 1); PG8_STAGE(PG8_SB(0, 0), b2, voffB);
            PG8_BAR; PG8_WAIT_L(0); PG8_MMA(0, 1, At, B1); PG8_BAR;
            PG8_LDA(At, 0, 1); PG8_STAGE(PG8_SA(0, 0), a2, voffA);
            PG8_BAR; PG8_WAIT_L(0); PG8_MMA(1, 0, At, B0); PG8_BAR; PG8_SCHED;
            PG8_STAGE(PG8_SB(0, 1), b2 + hstepB, voffB);
            PG8_WAIT_V(6); PG8_BAR; PG8_MMA(1, 1, At, B1); PG8_BAR;
            PG8_LDB(B0, 1, 0); PG8_SCHED; PG8_LDA(At, 1, 0); PG8_STAGE(PG8_SA(0, 1), a2 + hstepA, voffA);
            PG8_WAIT_L(8); PG8_BAR; PG8_WAIT_L(0); PG8_MMA(0, 0, At, B0); PG8_BAR; PG8_SCHED;
            PG8_LDB(B1, 1, 1); PG8_STAGE(PG8_SB(1, 0), b3, voffB);
            PG8_BAR; PG8_WAIT_L(0); PG8_MMA(0, 1, At, B1); PG8_BAR;
            PG8_LDA(At, 1, 1); PG8_STAGE(PG8_SA(1, 0), a3, voffA);
            PG8_BAR; PG8_WAIT_L(0); PG8_MMA(1, 0, At, B0); PG8_BAR; PG8_SCHED;
            PG8_STAGE(PG8_SB(1, 1), b3 + hstepB, voffB);
            PG8_WAIT_V(6); PG8_BAR; PG8_MMA(1, 1, At, B1); PG8_BAR;
            }
        }
        if constexpr (ALIGN_EPI) { if (wr == 0) PG8_BAR; }
        if constexpr (!Epi::AFTER_DRAIN) { E(acc, cur, wr, wc, fr, fq); S.done(cur); }
        if (!has_next) break;
#pragma unroll
        for (int a = 0; a < 2; ++a)
#pragma unroll
            for (int b = 0; b < 2; ++b)
#pragma unroll
                for (int m = 0; m < MT; ++m)
#pragma unroll
                    for (int n = 0; n < 2; ++n) acc[a][b][m][n] = (f32x4){0.f, 0.f, 0.f, 0.f};
        cur = nxt; cA = nA; cB = nB; ++ui;
        if constexpr (ALIGN_EPI) { if (wr == 1) PG8_BAR; }
    }
    PG8_WAIT_V(0);
    if constexpr (!ALIGN_EPI) { if (wr == 0) PG8_BAR; }
    PG8_BAR;
    if constexpr (Epi::AFTER_DRAIN) { E.fused(acc, cur, wr, wc, fr, fq, lds, wid, lane); S.done(cur); }
#undef PG8_SA
#undef PG8_SB
#undef PG8_STAGE
#undef PG8_LDA
#undef PG8_LDB
#undef PG8_MMA
#undef PG8_WAIT_V
#undef PG8_WAIT_L
#undef PG8_BAR
#undef PG8_SCHED
}
}
#define GAS __attribute__((address_space(1)))
#define LAS __attribute__((address_space(3)))
typedef unsigned short bf16;
typedef unsigned v4u __attribute__((ext_vector_type(4)));
typedef float f32x4 __attribute__((ext_vector_type(4)));
typedef short bf16x8 __attribute__((ext_vector_type(8)));
typedef GAS unsigned gu32;
typedef GAS unsigned long long gu64;
#define RLX_AGENT __ATOMIC_RELAXED, __HIP_MEMORY_SCOPE_AGENT
#define LDS_WAIT() asm volatile("s_waitcnt lgkmcnt(0)" ::: "memory")
#define VM_WAIT() asm volatile("s_waitcnt vmcnt(0)" ::: "memory")
__device__ __forceinline__ unsigned long long rt() { return __builtin_amdgcn_s_memrealtime(); }
__device__ __forceinline__ unsigned f2bf(float f) { unsigned u = __builtin_bit_cast(unsigned, f); return (u + 0x7fffu + ((u >> 16) & 1u)) >> 16; }
__device__ __forceinline__ unsigned pk2(float lo, float hi) { return f2bf(lo) | (f2bf(hi) << 16); }
#define XB_TMO      128
#define XB_XCNT(j)  (256  + 64 * (j))
#define XB_XSUB(j)  (1280 + 64 * (j))
#define XB_XGEN(j)  (2304 + 64 * (j))
#define XB_TOP      3328
#define XB_TOPGEN   3392
#define XCD_BAR_WORDS 3456
#define XB_SPIN_CAP (1u << 18)

__device__ __forceinline__ unsigned xb_ld(unsigned* p)              { return __hip_atomic_load(p, __ATOMIC_RELAXED, __HIP_MEMORY_SCOPE_AGENT); }
__device__ __forceinline__ unsigned xb_add(unsigned* p, unsigned v) { return __hip_atomic_fetch_add(p, v, __ATOMIC_RELAXED, __HIP_MEMORY_SCOPE_AGENT); }
__device__ __forceinline__ unsigned xb_xcc_id() { return (unsigned)__builtin_amdgcn_s_getreg((3 << 11) | 20) & 0xFu; }
#define XB_SPIN(cond, bar) do { unsigned _sp = 0; while (cond) { __builtin_amdgcn_s_sleep(1); \
    if ((++_sp & 255u) == 0u) { if (xb_ld(&(bar)[XB_TMO])) break; if (_sp > XB_SPIN_CAP) { atomicAdd(&(bar)[XB_TMO], 1u); break; } } } } while (0)

struct XcdBarrier {
    unsigned* bar; unsigned x;
    volatile LAS unsigned* st;
};

__device__ __forceinline__ XcdBarrier xcd_barrier_post(unsigned* bar, volatile LAS unsigned* st) {
    XcdBarrier b; b.bar = bar; b.x = xb_xcc_id(); b.st = st;
    if (threadIdx.x == 0) (void)xb_add(&bar[XB_XCNT(b.x)], 1u);
    return b;
}
__device__ __forceinline__ void xcd_barrier_complete(unsigned* bar, unsigned x, unsigned& nloc, unsigned& nx) {
    const unsigned G = gridDim.x * gridDim.y * gridDim.z;
    unsigned sum, cnt, mine, sp = 0u;
    for (;;) {
        sum = 0u; cnt = 0u; mine = 0u;
#pragma unroll
        for (unsigned j = 0; j < 16; ++j) { const unsigned c = xb_ld(&bar[XB_XCNT(j)]); sum += c; cnt += (c > 0u) ? 1u : 0u; mine = (j == x) ? c : mine; }
        if (sum == G) break;
        __builtin_amdgcn_s_sleep(1);
        if ((++sp & 255u) == 0u) { if (xb_ld(&bar[XB_TMO])) break; if (sp > XB_SPIN_CAP) { atomicAdd(&bar[XB_TMO], 1u); break; } }
    }
    nloc = mine > 0u ? mine : 1u; nx = cnt > 0u ? cnt : 1u;
}

__device__ __forceinline__ void xcd_barrier(const XcdBarrier& b) {
    asm volatile("s_waitcnt vmcnt(0)" ::: "memory");
    __syncthreads();
    if (threadIdx.x == 0) {
        unsigned* bar = b.bar;
        __builtin_amdgcn_s_waitcnt(0);
        unsigned nloc = b.st[0], nx = b.st[1];
        if (nloc == 0u) { xcd_barrier_complete(bar, b.x, nloc, nx); b.st[0] = nloc; b.st[1] = nx; }
        const unsigned old = xb_add(&bar[XB_XSUB(b.x)], 1u);
        const unsigned gen = old / nloc;
        if (old + 1u == (gen + 1u) * nloc) {
            __builtin_amdgcn_fence(__ATOMIC_RELEASE, "agent");
            asm volatile("s_waitcnt vmcnt(0)" ::: "memory");
            const unsigned og = xb_add(&bar[XB_TOP], 1u);
            const unsigned tg = og / nx;
            if (og + 1u == (tg + 1u) * nx) xb_add(&bar[XB_TOPGEN], 1u);
            else XB_SPIN(xb_ld(&bar[XB_TOPGEN]) == tg, bar);
            __builtin_amdgcn_fence(__ATOMIC_ACQUIRE, "agent");
            xb_add(&bar[XB_XGEN(b.x)], 1u);
            asm volatile("s_waitcnt vmcnt(0)" ::: "memory");
        } else {
            XB_SPIN(xb_ld(&bar[XB_XGEN(b.x)]) == gen, bar);
            __builtin_amdgcn_fence(__ATOMIC_ACQUIRE, "agent");
            asm volatile("s_waitcnt vmcnt(0)" ::: "memory");
        }
    }
    __syncthreads();
}

typedef float f32x16 __attribute__((ext_vector_type(16)));
typedef unsigned v2u __attribute__((ext_vector_type(2)));
typedef float f32x2v __attribute__((ext_vector_type(2)));
typedef short bf16x4 __attribute__((ext_vector_type(4)));

constexpr int NWAVES = 8, NTHR = 512;
constexpr int DM = 1024, NTOK = 12288, NCTX = 4096, DEPTH_L = 4, SEQC = 256, SEQL = 2048, PASTL = 256, SKL = 2304, DFF = 2816, NIN = 2048, NGU = 5632;
constexpr float EPS = 1e-6f;
constexpr float LOG2E = 1.4426950408889634f;
constexpr float QSCALE_A = 0.125f * LOG2E;
constexpr float QSCALE_B = 0.17677669529663687f * LOG2E;

constexpr size_t MiB = 1u << 20;
constexpr size_t WS_CTL = 0, CTL_ZERO_BYTES = 1 * MiB;
constexpr size_t WS_MOD = 1 * MiB;
constexpr size_t WS_WCT = WS_MOD + 512 * 1024;
constexpr size_t WS_WSB = WS_WCT + 128 * 1024;
constexpr size_t WS_ROPEA = WS_WSB + 512 * 1024;
constexpr size_t WS_ROPEB = WS_ROPEA + 8 * 1024;
constexpr size_t WS_LAM = WS_ROPEB + 4 * 1024;
constexpr size_t WS_PAR = 3 * MiB;
constexpr int P_GPREMIX = 0, P_GPOSTMIX = 4096, P_GPREFFN = 8192, P_GPOSTFFN = 12288, P_AQN = 16384, P_AKN = 16640, P_SUBLN = 16896, P_CSCALE = 17152, P_DVN = 18176, P_DBS = 19200, P_END = 21248;
constexpr size_t WS_WIN = 4 * MiB, WS_WOUT = 20 * MiB, WS_WGU = 28 * MiB, WS_WDN = 72 * MiB;
constexpr size_t WS_H = 94 * MiB, WS_QA = 118 * MiB, WS_QB = 124 * MiB, WS_KA = 130 * MiB, WS_VAT = 134 * MiB, WS_KB = 138 * MiB, WS_VBT = 146 * MiB;
constexpr size_t WS_CX = 154 * MiB, WS_U = 160 * MiB, WS_V = 166 * MiB, WS_MIX = 172 * MiB, WS_Y = 196 * MiB, WS_ACT = 244 * MiB;
constexpr size_t WS_KAC = 310 * MiB, WS_VATC = 311 * MiB, WS_KBC = 312 * MiB, WS_VBTC = 314 * MiB, WS_PARTIAL = 316 * MiB  , WS_END = 324 * MiB;
constexpr size_t KA_LAT = (size_t)16 * 2 * 256 * 64, KB_LAT = (size_t)16 * 4 * 256 * 64;
constexpr size_t OUT_AK = 12582912, OUT_AV = 14680064, OUT_BK = 16777216, OUT_BV = 20971520, OUT_TOTAL = 25165824;
constexpr int CW_BAR = 4096;
constexpr int CW_QUEUE = 16384;

constexpr int RING_BYTES = 131072, LDSCTL_OFF = RING_BYTES, MISC_OFF = LDSCTL_OFF + 320, LDS_BYTES = 147456;

struct KArgs { const float* in[31]; float* out; unsigned char* ws; };

#define CAS __attribute__((address_space(4)))
struct Ctx {
    const CAS unsigned long long* kp;
    float* out; unsigned char* ws;
    LAS unsigned char* lds; int tid, lane, wave, G, bid;
};
#define WSP(T, off) ((T*)(C.ws + (off)))
#define INP(i) ((const float*)C.kp[i])
#define REFRESH_KP() asm volatile("" : "+s"(C.kp))

__device__ __forceinline__ float wave_sum(float v) {
#pragma unroll
    for (int o = 1; o < 64; o <<= 1) v += __shfl_xor(v, o);
    return v;
}
__device__ __forceinline__ unsigned pkbf(float lo, float hi) { return pg8::cvt_pk_bf16(lo, hi); }
__device__ __forceinline__ v2u pk4(f32x4 v) { v2u r; r.x = pkbf(v[0], v[1]); r.y = pkbf(v[2], v[3]); return r; }
__device__ __forceinline__ float bf2f(unsigned short b) { return __builtin_bit_cast(float, (unsigned)b << 16); }
__device__ __forceinline__ float gelu_tanh(float x) {
    const float y = 0.7978845608028654f * (x + 0.044715f * x * x * x);
    const float e = __expf(2.f * y);
    const float t = 1.f - 2.f / (e + 1.f);
    return 0.5f * x * (1.f + t);
}
__device__ __forceinline__ float silu_f(float x) { return x / (1.f + __expf(-x)); }
__device__ __forceinline__ int cond_of_row(int row) { return row < NCTX ? 0 : 1 + ((row - NCTX) >> 11); }

__device__ __forceinline__ f32x2v rope_cs(int pos, int f) {
    const float inv = __builtin_amdgcn_exp2f(-(float)f * 0.83048202372184059f);
    const float ang = (float)pos * inv;
    const float k = __builtin_rintf(ang * 0.15915494309189535f);
    float r = __builtin_fmaf(-k, 6.2831854820251465f, ang); r = __builtin_fmaf(-k, -1.7484555e-7f, r);
    const float r2 = r * r; float sn = r, cs = 1.f, ts = r, tc = 1.f;
#pragma unroll 1
    for (int n = 1; n <= 10; ++n) { tc *= -r2 / (float)((2 * n - 1) * (2 * n)); ts *= -r2 / (float)((2 * n) * (2 * n + 1)); cs += tc; sn += ts; }
    return (f32x2v){cs, sn};
}
template <int KIND> __device__ __forceinline__ int rowmap(int n) {
    if (KIND == 1) { const int pn = n >> 8, wc = (n >> 6) & 3, bj = (n >> 5) & 1, q = n & 31; return (pn << 8) + (bj << 7) + (wc << 5) + q; }
    if (KIND == 2) return ((n >> 7) << 8) + (n & 127);
    if (KIND == 3) return ((n >> 7) << 8) + 128 + (n & 127);
    return n;
}
template <int KIND> __device__ __forceinline__ void transpose_item(const float* W, int K, int N, bf16* WT, LAS unsigned char* scr, int item, int lane) {
    const int nblk = N / 64, kb = item / nblk, nb = item % nblk, k0 = 64 * kb, n0 = 64 * nb;
    const int rg = lane >> 4, c4 = lane & 15;
    const float* src = W + (size_t)(k0 + 16 * rg) * N + n0 + 4 * c4;
    f32x4 v[16];
#pragma unroll
    for (int i = 0; i < 16; ++i) v[i] = *(const f32x4*)(src + (size_t)i * N);
    LAS bf16* T = (LAS bf16*)scr;
#pragma unroll
    for (int e = 0; e < 4; ++e) {
        v4u lo, hi;
        lo.x = pkbf(v[0][e], v[1][e]); lo.y = pkbf(v[2][e], v[3][e]); lo.z = pkbf(v[4][e], v[5][e]); lo.w = pkbf(v[6][e], v[7][e]);
        hi.x = pkbf(v[8][e], v[9][e]); hi.y = pkbf(v[10][e], v[11][e]); hi.z = pkbf(v[12][e], v[13][e]); hi.w = pkbf(v[14][e], v[15][e]);
        *(LAS v4u*)(T + (4 * c4 + e) * 72 + 16 * rg) = lo; *(LAS v4u*)(T + (4 * c4 + e) * 72 + 16 * rg + 8) = hi;
    }
    LDS_WAIT(); asm volatile("" ::: "memory");
#pragma unroll
    for (int j = 0; j < 8; ++j) { const int n = (lane >> 3) + 8 * j, ch = lane & 7;
        const v4u o = *(const LAS v4u*)(T + n * 72 + 8 * ch);
        *(v4u*)(WT + (size_t)rowmap<KIND>(n0 + n) * K + k0 + 8 * ch) = o; }
    LDS_WAIT(); asm volatile("" ::: "memory");
}

__device__ __forceinline__ void prep_caches(const Ctx& Cin) {
    Ctx C = Cin; REFRESH_KP();
    const int gt = C.bid * NTHR + C.tid, NGT = C.G * NTHR;
    const float* cak = INP(2); const float* cav = INP(3); const float* cbk = INP(4); const float* cbv = INP(5);
    bf16* KA = WSP(bf16, WS_KAC); bf16* VAT = WSP(bf16, WS_VATC); bf16* KB = WSP(bf16, WS_KBC); bf16* VBT = WSP(bf16, WS_VBTC);
    for (int i = gt; i < 4 * 4 * 256 * 128; i += NGT) {
        const int d = i & 63, kvh = (i >> 6) & 1, key = (i >> 7) & 255, l = (i >> 15) & 3, b = i >> 17;
        const size_t hb = (size_t)(l * 4 + b) * 2 + kvh;
        KA[(hb * 256 + key) * 64 + d] = (bf16)f2bf(cak[i]);
        VAT[(hb * 256 + key) * 64 + d] = (bf16)f2bf(cav[i]);
    }
    for (int i = gt; i < 4 * 4 * 256 * 256; i += NGT) {
        const int d = i & 63, h = (i >> 6) & 3, key = (i >> 8) & 255, l = (i >> 16) & 3, b = i >> 18;
        const size_t hb = (size_t)(l * 4 + b) * 4 + h;
        KB[(hb * 256 + key) * 64 + d] = (bf16)f2bf(cbk[i]);
        VBT[(hb * 256 + key) * 64 + d] = (bf16)f2bf(cbv[i]);
    }
}

__device__ __forceinline__ void phase0(const Ctx& Cin) {
    Ctx C = Cin;
    {
        LAS unsigned char* scr = C.lds + C.wave * 16384;
        const int gw = C.bid * NWAVES + C.wave, NGW = C.G * NWAVES;
        constexpr int I_MOD = DEPTH_L * 24 * 16;
        constexpr int I_IN = 16 * 32, I_OUT = 16 * 16, I_G = 16 * 44, I_D = 44 * 16, I_L = I_IN + I_OUT + 2 * I_G + I_D;
        for (int it = gw; it < I_MOD + DEPTH_L * I_L; it += NGW) {
            REFRESH_KP();
            if (it < I_MOD) {
                const int kc = it & 15, slab = (it >> 4) % 24, l = it / (16 * 24);
                LAS float* sc = (LAS float*)scr;
#pragma unroll
                for (int ci = 0; ci < 5; ++ci) { const float cv = ci == 0 ? INP(7)[64 * kc + C.lane] : INP(6)[(ci - 1) * 1024 + 64 * kc + C.lane]; sc[ci * 64 + C.lane] = silu_f(cv); }
                LDS_WAIT(); asm volatile("" ::: "memory");
                const float* W = INP(8) + ((size_t)l * DM + 64 * kc) * 6144 + 256 * slab + 4 * C.lane;
                f32x4 acc[5];
#pragma unroll
                for (int ci = 0; ci < 5; ++ci) acc[ci] = (f32x4){0.f, 0.f, 0.f, 0.f};
#pragma unroll 16
                for (int kk = 0; kk < 64; ++kk) { const f32x4 w = *(const f32x4*)(W + (size_t)kk * 6144);
#pragma unroll
                    for (int ci = 0; ci < 5; ++ci) acc[ci] += w * sc[ci * 64 + kk]; }
                float* part = WSP(float, WS_PARTIAL) + ((size_t)(l * 24 + slab) * 16 + kc) * 5 * 256 + 4 * C.lane;
#pragma unroll
                for (int ci = 0; ci < 5; ++ci) *(f32x4*)(part + ci * 256) = acc[ci];
                LDS_WAIT(); asm volatile("" ::: "memory");
                continue;
            }
            const int l = (it - I_MOD) / I_L; int r = (it - I_MOD) % I_L;
            if (r < I_IN) { transpose_item<1>(INP(14) + (size_t)l * DM * NIN, DM, NIN, WSP(bf16, WS_WIN) + (size_t)l * NIN * DM, scr, r, C.lane); continue; } r -= I_IN;
            if (r < I_OUT) { transpose_item<0>(INP(15) + (size_t)l * DM * DM, DM, DM, WSP(bf16, WS_WOUT) + (size_t)l * DM * DM, scr, r, C.lane); continue; } r -= I_OUT;
            if (r < I_G) { transpose_item<2>(INP(28) + (size_t)l * DM * DFF, DM, DFF, WSP(bf16, WS_WGU) + (size_t)l * NGU * DM, scr, r, C.lane); continue; } r -= I_G;
            if (r < I_G) { transpose_item<3>(INP(29) + (size_t)l * DM * DFF, DM, DFF, WSP(bf16, WS_WGU) + (size_t)l * NGU * DM, scr, r, C.lane); continue; } r -= I_G;
            transpose_item<0>(INP(30) + (size_t)l * DFF * DM, DFF, DM, WSP(bf16, WS_WDN) + (size_t)l * DM * DFF, scr, r, C.lane);
        }
    }
    {
        REFRESH_KP();
        const int gt = C.bid * NTHR + C.tid, NGT = C.G * NTHR;
        for (int i = gt; i < 4 * 4 * 64 * 64; i += NGT) { const int c = i & 63, e = (i >> 6) & 63, lg = i >> 12; WSP(bf16, WS_WCT)[i] = (bf16)f2bf(INP(23)[((size_t)lg * 64 + c) * 64 + e]); }
        for (int i = gt; i < 4 * 4 * 128 * 128; i += NGT) WSP(bf16, WS_WSB)[i] = (bf16)f2bf(INP(26)[i]);
        for (int i = gt; i < 64 * 16; i += NGT) { const int pos = i >> 4, f = i & 15; WSP(f32x2v, WS_ROPEA)[i] = rope_cs(pos, f); }
        for (int i = gt; i < 64 * 8; i += NGT) { const int pos = i >> 3, f = i & 7; WSP(f32x2v, WS_ROPEB)[i] = rope_cs(pos, 2 * f); }
        if (gt < 4) { const int l = gt; float s1 = 0.f, s2 = 0.f;
            for (int i = 0; i < 32; ++i) { s1 += INP(18)[l * 32 + i] * INP(19)[l * 32 + i]; s2 += INP(20)[l * 32 + i] * INP(21)[l * 32 + i]; }
            const float lam_init = 0.8f - 0.6f * expf(-0.3f * (float)l);
            WSP(float, WS_LAM)[l] = expf(s1) - expf(s2) + lam_init; }
    }
    {
        REFRESH_KP();
        const int gt = C.bid * NTHR + C.tid, NGT = C.G * NTHR; float* P = WSP(float, WS_PAR);
        for (int i = gt; i < 4096; i += NGT) { P[P_GPREMIX + i] = INP(10)[i]; P[P_GPOSTMIX + i] = INP(11)[i]; P[P_GPREFFN + i] = INP(12)[i]; P[P_GPOSTFFN + i] = INP(13)[i]; }
        for (int i = gt; i < 256; i += NGT) { P[P_AQN + i] = INP(16)[i]; P[P_AKN + i] = INP(17)[i]; P[P_SUBLN + i] = INP(22)[i]; }
        for (int i = gt; i < 1024; i += NGT) { P[P_CSCALE + i] = INP(24)[i]; P[P_DVN + i] = INP(25)[i]; }
        for (int i = gt; i < 2048; i += NGT) P[P_DBS + i] = INP(27)[i];
    }
    prep_caches(C);
}

template <bool HAS_Y, bool FROM_IN>
__device__ __forceinline__ void rowwise(const Ctx& C, const bool HAS_H, const float* gate_mod  , const float* gpost, const float* gpre, const float* scale_mod, const float* shift_mod) {
    const int gw = C.bid * NWAVES + C.wave, NGW = C.G * NWAVES;
    const float* Y = WSP(float, WS_Y); bf16* H = WSP(bf16, WS_H);
    for (int row = gw; row < NTOK; row += NGW) {
        const int ci = cond_of_row(row);
        const float* xin = FROM_IN ? (row < NCTX ? INP(0) + (size_t)row * DM : INP(1) + (size_t)(row - NCTX) * DM) : C.out + (size_t)row * DM;
        f32x4 x[4];
#pragma unroll
        for (int j = 0; j < 4; ++j) x[j] = ((const f32x4*)xin)[C.lane + 64 * j];
        if (HAS_Y) {
            f32x4 y[4]; float s = 0.f;
#pragma unroll
            for (int j = 0; j < 4; ++j) { y[j] = ((const f32x4*)(Y + (size_t)row * DM))[C.lane + 64 * j]; s += (y[j][0] * y[j][0] + y[j][1] * y[j][1]) + (y[j][2] * y[j][2] + y[j][3] * y[j][3]); }
            const float r = rsqrtf(wave_sum(s) * (1.f / DM) + EPS);
#pragma unroll
            for (int j = 0; j < 4; ++j) { const f32x4 g = ((const f32x4*)(gate_mod + (size_t)ci * 6144))[C.lane + 64 * j]; const f32x4 gp = ((const f32x4*)gpost)[C.lane + 64 * j];
                x[j] = x[j] + g * (y[j] * r * gp); ((f32x4*)(C.out + (size_t)row * DM))[C.lane + 64 * j] = x[j]; }
        }
        if (HAS_H) {
            float s = 0.f;
#pragma unroll
            for (int j = 0; j < 4; ++j) s += (x[j][0] * x[j][0] + x[j][1] * x[j][1]) + (x[j][2] * x[j][2] + x[j][3] * x[j][3]);
            const float r = rsqrtf(wave_sum(s) * (1.f / DM) + EPS);
#pragma unroll
            for (int j = 0; j < 4; ++j) { const f32x4 gp = ((const f32x4*)gpre)[C.lane + 64 * j]; const f32x4 sc = ((const f32x4*)(scale_mod + (size_t)ci * 6144))[C.lane + 64 * j]; const f32x4 sh = ((const f32x4*)(shift_mod + (size_t)ci * 6144))[C.lane + 64 * j];
                const f32x4 h = (x[j] * r * gp) * (sc + 1.f) + sh; ((v2u*)(H + (size_t)row * DM))[C.lane + 64 * j] = pk4(h); }
        }
    }
}

template <int MT> struct EpiF32 {
    static constexpr bool PERM = false, AFTER_DRAIN = false;
    float* Y; int ldc;
    __device__ __forceinline__ void operator()(const f32x4 (&acc)[2][2][MT][2], const pg8::Unit& u, int wr, int wc, int fr_in, int fq_in) const {
        int fr = fr_in, fq = fq_in; asm volatile("" : "+v"(fr), "+v"(fq));
#pragma unroll
        for (int ai = 0; ai < 2; ++ai)
#pragma unroll
            for (int m = 0; m < MT; ++m) { float* rowp = Y + (size_t)(u.pm * (64 * MT) + ai * (32 * MT) + wr * (16 * MT) + m * 16 + fr) * ldc + u.pn * 256 + wc * 32 + 4 * fq;
#pragma unroll
                for (int bj = 0; bj < 2; ++bj)
#pragma unroll
                    for (int n = 0; n < 2; ++n) *(f32x4*)(rowp + bj * 128 + n * 16) = acc[ai][bj][m][n]; }
    }
};
template <int MT> struct EpiGLU {
    static constexpr bool PERM = false, AFTER_DRAIN = false;
    bf16* O;
    __device__ __forceinline__ void operator()(const f32x4 (&acc)[2][2][MT][2], const pg8::Unit& u, int wr, int wc, int fr_in, int fq_in) const {
        int fr = fr_in, fq = fq_in; asm volatile("" : "+v"(fr), "+v"(fq));
#pragma unroll
        for (int ai = 0; ai < 2; ++ai)
#pragma unroll
            for (int m = 0; m < MT; ++m) { bf16* rowp = O + (size_t)(u.pm * (64 * MT) + ai * (32 * MT) + wr * (16 * MT) + m * 16 + fr) * DFF + u.pn * 128 + wc * 32 + 4 * fq;
#pragma unroll
                for (int n = 0; n < 2; ++n) { const f32x4 g = acc[ai][0][m][n], up = acc[ai][1][m][n]; f32x4 o;
#pragma unroll
                    for (int e = 0; e < 4; ++e) o[e] = silu_f(g[e]) * up[e];
                    *(v2u*)(rowp + n * 16) = pk4(o); } }
    }
};
template <int MT> struct EpiProj {
    static constexpr bool PERM = false, AFTER_DRAIN = false;
    unsigned char* ws; float* out; int layer;
    __device__ __forceinline__ void operator()(const f32x4 (&acc)[2][2][MT][2], const pg8::Unit& u, int wr, int wc, int fr_in, int fq_in) const {
        int fr = fr_in, fq = fq_in; asm volatile("" : "+v"(fr), "+v"(fq));
        const int pn = u.pn;
        const f32x2v* ropeA = (const f32x2v*)(ws + WS_ROPEA); const f32x2v* ropeB = (const f32x2v*)(ws + WS_ROPEB);
#pragma unroll
        for (int ai = 0; ai < 2; ++ai)
#pragma unroll
            for (int m = 0; m < MT; ++m) {
                const int rowg = u.pm * (64 * MT) + ai * (32 * MT) + wr * (16 * MT) + m * 16, row = rowg + fr;
                const bool lat = rowg >= NCTX;
                int b, s; if (lat) { const int rl = row - NCTX; b = rl >> 11; s = rl & 2047; } else { b = row >> 8; s = row & 255; }
                const int prow = s >> 6, pcol = s & 63;
                f32x4 v[2][2];
#pragma unroll
                for (int bj = 0; bj < 2; ++bj)
#pragma unroll
                    for (int n = 0; n < 2; ++n) v[bj][n] = acc[ai][bj][m][n];
                const int d0 = 4 * fq;
                if (pn == 0 || (pn == 1 && wc < 2)) {
                    float ss = 0.f;
#pragma unroll
                    for (int bj = 0; bj < 2; ++bj)
#pragma unroll
                        for (int n = 0; n < 2; ++n) ss += (v[bj][n][0] * v[bj][n][0] + v[bj][n][1] * v[bj][n][1]) + (v[bj][n][2] * v[bj][n][2] + v[bj][n][3] * v[bj][n][3]);
                    ss += __shfl_xor(ss, 16); ss += __shfl_xor(ss, 32);
                    const float r = rsqrtf(ss * (1.f / 64.f) + EPS);
                    const float* gn = (const float*)(ws + WS_PAR) + (pn == 0 ? P_AQN : P_AKN) + 64 * layer;
#pragma unroll
                    for (int bj = 0; bj < 2; ++bj)
#pragma unroll
                        for (int n = 0; n < 2; ++n) v[bj][n] = v[bj][n] * r * *(const f32x4*)(gn + 32 * bj + 16 * n + d0);
                    if (pn == 1 && !lat) {
                        float* o = out + OUT_AK + (((size_t)(b * 4 + layer) * 256 + s) * 128 + 64 * wc);
#pragma unroll
                        for (int bj = 0; bj < 2; ++bj)
#pragma unroll
                            for (int n = 0; n < 2; ++n) *(f32x4*)(o + 32 * bj + 16 * n + d0) = v[bj][n];
                    }
                    if (lat) {
#pragma unroll
                        for (int bj = 0; bj < 2; ++bj) { const int pos = bj == 0 ? prow : pcol;
#pragma unroll
                            for (int e = 0; e < 4; ++e) { const f32x2v cs = ropeA[pos * 16 + d0 + e]; const float x1 = v[bj][0][e], x2 = v[bj][1][e];
                                v[bj][0][e] = x1 * cs.x - x2 * cs.y; v[bj][1][e] = x2 * cs.x + x1 * cs.y; } }
                    }
                    if (pn == 0) {
                        bf16* o = (bf16*)(ws + WS_QA) + (size_t)row * 256 + 64 * wc;
#pragma unroll
                        for (int bj = 0; bj < 2; ++bj)
#pragma unroll
                            for (int n = 0; n < 2; ++n) *(v2u*)(o + 32 * bj + 16 * n + d0) = pk4(v[bj][n] * QSCALE_A);
                    } else {
                        bf16* o = (bf16*)(ws + WS_KA) + (lat ? KA_LAT + ((size_t)(b * 2 + wc) * SEQL + s) * 64 : ((size_t)(b * 2 + wc) * 256 + s) * 64);
#pragma unroll
                        for (int bj = 0; bj < 2; ++bj)
#pragma unroll
                            for (int n = 0; n < 2; ++n) *(v2u*)(o + 32 * bj + 16 * n + d0) = pk4(v[bj][n]);
                    }
                } else if (pn == 1) {
                    const int h = wc - 2;
                    if (!lat) { float* o = out + OUT_AV + (((size_t)(b * 4 + layer) * 256 + s) * 128 + 64 * h);
#pragma unroll
                        for (int bj = 0; bj < 2; ++bj)
#pragma unroll
                            for (int n = 0; n < 2; ++n) *(f32x4*)(o + 32 * bj + 16 * n + d0) = v[bj][n]; }
                    bf16* o = (bf16*)(ws + WS_VAT) + (lat ? KA_LAT + ((size_t)(b * 2 + h) * SEQL + s) * 64 : ((size_t)(b * 2 + h) * 256 + s) * 64);
#pragma unroll
                    for (int bj = 0; bj < 2; ++bj)
#pragma unroll
                        for (int n = 0; n < 2; ++n) *(v2u*)(o + 32 * bj + 16 * n + d0) = pk4(v[bj][n]);
                } else if (pn == 2 || pn == 3) {
                    if (pn == 3 && !lat) { float* o = out + OUT_BK + (((size_t)(b * 4 + layer) * 256 + s) * 256 + 64 * wc);
#pragma unroll
                        for (int bj = 0; bj < 2; ++bj)
#pragma unroll
                            for (int n = 0; n < 2; ++n) *(f32x4*)(o + 32 * bj + 16 * n + d0) = v[bj][n]; }
                    if (lat) {
#pragma unroll
                        for (int bj = 0; bj < 2; ++bj)
#pragma unroll
                            for (int n = 0; n < 2; ++n) { const int pos = n == 0 ? prow : pcol;
#pragma unroll
                                for (int e = 0; e < 4; ++e) { const f32x2v cs = ropeB[pos * 8 + 4 * (fq & 1) + e]; const float mine = v[bj][n][e]; const float other = __shfl_xor(mine, 32);
                                    v[bj][n][e] = fq < 2 ? mine * cs.x - other * cs.y : mine * cs.x + other * cs.y; } }
                    }
                    if (pn == 2) { bf16* o = (bf16*)(ws + WS_QB) + (size_t)row * 256 + 64 * wc;
#pragma unroll
                        for (int bj = 0; bj < 2; ++bj)
#pragma unroll
                            for (int n = 0; n < 2; ++n) *(v2u*)(o + 32 * bj + 16 * n + d0) = pk4(v[bj][n] * QSCALE_B);
                    } else { bf16* o = (bf16*)(ws + WS_KB) + (lat ? KB_LAT + ((size_t)(b * 4 + wc) * SEQL + s) * 64 : ((size_t)(b * 4 + wc) * 256 + s) * 64);
#pragma unroll
                        for (int bj = 0; bj < 2; ++bj)
#pragma unroll
                            for (int n = 0; n < 2; ++n) *(v2u*)(o + 32 * bj + 16 * n + d0) = pk4(v[bj][n]); }
                } else if (pn == 4) {
                    if (!lat) { float* o = out + OUT_BV + (((size_t)(b * 4 + layer) * 256 + s) * 256 + 64 * wc);
#pragma unroll
                        for (int bj = 0; bj < 2; ++bj)
#pragma unroll
                            for (int n = 0; n < 2; ++n) *(f32x4*)(o + 32 * bj + 16 * n + d0) = v[bj][n]; }
                    bf16* o = (bf16*)(ws + WS_VBT) + (lat ? KB_LAT + ((size_t)(b * 4 + wc) * SEQL + s) * 64 : ((size_t)(b * 4 + wc) * 256 + s) * 64);
#pragma unroll
                    for (int bj = 0; bj < 2; ++bj)
#pragma unroll
                        for (int n = 0; n < 2; ++n) *(v2u*)(o + 32 * bj + 16 * n + d0) = pk4(v[bj][n]);
                } else {
                    bf16* o = (bf16*)(ws + (pn == 5 ? WS_CX : pn == 6 ? WS_U : WS_V)) + (size_t)row * 256 + 64 * wc;
#pragma unroll
                    for (int bj = 0; bj < 2; ++bj)
#pragma unroll
                        for (int n = 0; n < 2; ++n) { f32x4 t = v[bj][n];
                            if (pn != 5) {
#pragma unroll
                                for (int e = 0; e < 4; ++e) t[e] = gelu_tanh(t[e]); }
                            *(v2u*)(o + 32 * bj + 16 * n + d0) = pk4(t); }
                }
            }
    }
};

constexpr int KS_STRIDE = 72, VS_STRIDE = 68, VS_OFF = 9216;
#define MFMA32(a, b, c) __builtin_amdgcn_mfma_f32_32x32x16_bf16(a, b, c, 0, 0, 0)
#define MFMA16(a, b, c) __builtin_amdgcn_mfma_f32_16x16x32_bf16(a, b, c, 0, 0, 0)

__device__ __forceinline__ bf16x8 pack8(const f32x16& p, int s) {
    v4u r; r.x = pkbf(p[8 * s + 0], p[8 * s + 1]); r.y = pkbf(p[8 * s + 2], p[8 * s + 3]); r.z = pkbf(p[8 * s + 4], p[8 * s + 5]); r.w = pkbf(p[8 * s + 6], p[8 * s + 7]);
    return __builtin_bit_cast(bf16x8, r);
}
__device__ __forceinline__ float max16(const f32x16& s) {
    float a = fmaxf(fmaxf(s[0], s[1]), fmaxf(s[2], s[3])), b = fmaxf(fmaxf(s[4], s[5]), fmaxf(s[6], s[7]));
    float c = fmaxf(fmaxf(s[8], s[9]), fmaxf(s[10], s[11])), d = fmaxf(fmaxf(s[12], s[13]), fmaxf(s[14], s[15]));
    return fmaxf(fmaxf(a, b), fmaxf(c, d));
}
constexpr float SUM_LIM = 4096.f;
template <bool REL>
__device__ __forceinline__ bool softmax_fast(f32x16& sa, f32x16& sb, float& l_run, float m_run) {
    float sum = 0.f;
#pragma unroll
    for (int i = 0; i < 16; ++i) { sa[i] = __builtin_amdgcn_exp2f(REL ? sa[i] : sa[i] - m_run); sb[i] = __builtin_amdgcn_exp2f(REL ? sb[i] : sb[i] - m_run); sum += sa[i] + sb[i]; }
    const bool ok = __all(sum <= SUM_LIM);
    if (ok) l_run += sum;
    return ok;
}
template <int NO, bool REL>
__device__ __forceinline__ void softmax_slow(f32x16& sa, f32x16& sb, float& m_run, f32x16& nm, float& l_run, f32x16 (&O)[NO], bool first) {
    float mx = fmaxf(max16(sa), max16(sb)); mx = fmaxf(mx, __shfl_xor(mx, 32));
    if (!REL) mx -= m_run;
    const float d = first ? mx : fmaxf(mx, 0.f);
    if (!REL) {
#pragma unroll
        for (int i = 0; i < 16; ++i) { sa[i] -= m_run; sb[i] -= m_run; } }
    m_run += d;
    if (REL) {
#pragma unroll
        for (int i = 0; i < 16; ++i) nm[i] = -m_run; }
    if (!first) { const float alpha = __builtin_amdgcn_exp2f(-d); l_run *= alpha;
#pragma unroll
        for (int k = 0; k < NO; ++k) O[k] = O[k] * alpha; }
    float sum = 0.f;
#pragma unroll
    for (int i = 0; i < 16; ++i) { sa[i] = __builtin_amdgcn_exp2f(sa[i] - d); sb[i] = __builtin_amdgcn_exp2f(sb[i] - d); sum += sa[i] + sb[i]; }
    l_run += sum;
}
constexpr int ATT_TILE = 8192, ATT_BUF = 2 * ATT_TILE;
template <int NK>
__device__ __forceinline__ void score_map(const LAS bf16* Ks, int r, int hh, int swz, int c0, const bf16x8* qf, const f32x16& nm, f32x16& sa, f32x16& sb) {
    sa = nm; sb = nm;
#pragma unroll
    for (int kk = 0; kk < NK; ++kk) {
        const int pc = ((c0 + 2 * kk + hh) ^ swz) * 8;
        const bf16x8 ka = *(const LAS bf16x8*)(Ks + r * 64 + pc), kb = *(const LAS bf16x8*)(Ks + (32 + r) * 64 + pc);
        sa = MFMA32(ka, qf[kk], sa); sb = MFMA32(kb, qf[kk], sb); }
}
typedef short s16x4 __attribute__((ext_vector_type(4)));
__device__ __forceinline__ bf16x8 ld_vfrag(const LAS bf16* Vs, int vb0, int vb1, int s) {
    const s16x4 lo = __builtin_amdgcn_ds_read_tr16_b64_v4i16((LAS s16x4*)(Vs + vb0 + 1024 * s)), hi = __builtin_amdgcn_ds_read_tr16_b64_v4i16((LAS s16x4*)(Vs + vb1 + 1024 * s));
    return (bf16x8){lo[0], lo[1], lo[2], lo[3], hi[0], hi[1], hi[2], hi[3]};
}
__device__ __forceinline__ int swz_v(int key) { return (((key >> 1) & 1) << 2) | ((key >> 2) & 3); }
template <bool DIFF>
__device__ __forceinline__ void attn_unit(const Ctx& C, const bf16* Q  , const bf16* K0, const bf16* V0, int nt0, const bf16* K1, const bf16* V1, int nt1,
                                          bf16* O  , float lam, float post_scale, const float* subln) {
    const int r = C.lane & 31, hh = C.lane >> 5, w = C.wave, swz = (r >> 1) & 7;
    const bf16* qrow = Q + (size_t)(32 * w + r) * 256;
    bf16x8 qf[4];
#pragma unroll
    for (int kk = 0; kk < 4; ++kk) qf[kk] = *(const bf16x8*)(qrow + 16 * kk + 8 * hh);
    f32x16 O0[2], O1[2], nm0;
#pragma unroll
    for (int i = 0; i < 16; ++i) { O0[0][i] = 0.f; O0[1][i] = 0.f; O1[0][i] = 0.f; O1[1][i] = 0.f; nm0[i] = 0.f; }
    float m0 = 0.f, l0 = 0.f, m1 = 0.f, l1 = 0.f;
    const int nt = nt0 + nt1;
    const int drow = 8 * w + (C.lane >> 3), dch = ((C.lane & 7) ^ ((drow >> 1) & 7)) * 8, dchv = ((C.lane & 7) ^ swz_v(drow)) * 8;
    int vb[2][2];
#pragma unroll
    for (int wv = 0; wv < 2; ++wv)
#pragma unroll
        for (int dt = 0; dt < 2; ++dt) { const int i = C.lane & 15, key = 8 * wv + 4 * hh + (i >> 2), d = 32 * dt + 16 * ((C.lane >> 4) & 1) + 4 * (i & 3); vb[wv][dt] = key * 64 + (((d >> 3) ^ swz_v(key)) * 8) + (d & 7); }
    const LAS unsigned char* ldsw = C.lds + w * 1024;
#define ATT_DMA(tl) do { const int tg = (tl); const bool s0 = tg < nt0; const int tt = s0 ? tg : tg - nt0; const bf16* Kp = s0 ? K0 : K1; const bf16* Vp = s0 ? V0 : V1; const int bo = (tg % 3) * ATT_BUF; \
        __builtin_amdgcn_global_load_lds((const unsigned*)(Kp + (size_t)(64 * tt + drow) * 64 + dch), (LAS unsigned*)(ldsw + bo), 16, 0, 0); \
        __builtin_amdgcn_global_load_lds((const unsigned*)(Vp + (size_t)(64 * tt + drow) * 64 + dchv), (LAS unsigned*)(ldsw + bo + ATT_TILE), 16, 0, 0); } while (0)
    __syncthreads();
    ATT_DMA(0);
    if (nt > 1) ATT_DMA(1);
#pragma unroll 1
    for (int t = 0; t < nt; ++t) {
        if (t + 1 < nt) asm volatile("s_waitcnt vmcnt(2)" ::: "memory"); else asm volatile("s_waitcnt vmcnt(0)" ::: "memory");
        __builtin_amdgcn_s_barrier();
        asm volatile("" ::: "memory");
        if (t + 2 < nt) ATT_DMA(t + 2);
        const LAS bf16* Ks = (const LAS bf16*)(C.lds + (t % 3) * ATT_BUF); const LAS bf16* Vs = (const LAS bf16*)(C.lds + (t % 3) * ATT_BUF + ATT_TILE);
        f32x16 sa, sb;
        if (!DIFF) {
            score_map<4>(Ks, r, hh, swz, 0, qf, nm0, sa, sb);
            if (t == 0 || !softmax_fast<true>(sa, sb, l0, 0.f)) { score_map<4>(Ks, r, hh, swz, 0, qf, nm0, sa, sb); softmax_slow<2, true>(sa, sb, m0, nm0, l0, O0, t == 0); }
#pragma unroll
            for (int s = 0; s < 4; ++s) {
                const bf16x8 pf = s < 2 ? pack8(sa, s) : pack8(sb, s - 2);
#pragma unroll
                for (int dt = 0; dt < 2; ++dt) O0[dt] = MFMA32(ld_vfrag(Vs, vb[0][dt], vb[1][dt], s), pf, O0[dt]);
            }
        } else {
            score_map<2>(Ks, r, hh, swz, 0, qf, nm0, sa, sb);
            if (t == 0 || !softmax_fast<false>(sa, sb, l0, m0)) { score_map<2>(Ks, r, hh, swz, 0, qf, nm0, sa, sb); softmax_slow<2, false>(sa, sb, m0, nm0, l0, O0, t == 0); }
            bf16x8 pf0[4]; pf0[0] = pack8(sa, 0); pf0[1] = pack8(sa, 1); pf0[2] = pack8(sb, 0); pf0[3] = pack8(sb, 1);
            __builtin_amdgcn_sched_barrier(0);
            score_map<2>(Ks, r, hh, swz, 4, qf + 2, nm0, sa, sb);
            if (t == 0 || !softmax_fast<false>(sa, sb, l1, m1)) { score_map<2>(Ks, r, hh, swz, 4, qf + 2, nm0, sa, sb); softmax_slow<2, false>(sa, sb, m1, nm0, l1, O1, t == 0); }
#pragma unroll
            for (int s = 0; s < 4; ++s) {
                const bf16x8 pf1 = s < 2 ? pack8(sa, s) : pack8(sb, s - 2);
#pragma unroll
                for (int dt = 0; dt < 2; ++dt) { const bf16x8 vf = ld_vfrag(Vs, vb[0][dt], vb[1][dt], s); O0[dt] = MFMA32(vf, pf0[s], O0[dt]); O1[dt] = MFMA32(vf, pf1, O1[dt]); }
            }
        }
    }
#undef ATT_DMA
    l0 += __shfl_xor(l0, 32); const float inv0 = 1.f / l0;
    bf16* orow = O + (size_t)(32 * w + r) * DM;
    if (!DIFF) {
#pragma unroll
        for (int dt = 0; dt < 2; ++dt)
#pragma unroll
            for (int g = 0; g < 4; ++g) { f32x4 o = {O0[dt][4 * g] * inv0, O0[dt][4 * g + 1] * inv0, O0[dt][4 * g + 2] * inv0, O0[dt][4 * g + 3] * inv0};
                *(v2u*)(orow + 32 * dt + 8 * g + 4 * hh) = pk4(o); }
    } else {
        l1 += __shfl_xor(l1, 32); const float inv1 = lam / l1;
        float ss = 0.f;
#pragma unroll
        for (int dt = 0; dt < 2; ++dt)
#pragma unroll
            for (int i = 0; i < 16; ++i) { const float o = O0[dt][i] * inv0 - O1[dt][i] * inv1; O0[dt][i] = o; ss += o * o; }
        ss += __shfl_xor(ss, 32);
        const float rr = rsqrtf(ss * (1.f / 64.f) + EPS) * post_scale;
#pragma unroll
        for (int dt = 0; dt < 2; ++dt)
#pragma unroll
            for (int g = 0; g < 4; ++g) { const f32x4 gn = *(const f32x4*)(subln + 32 * dt + 8 * g + 4 * hh);
                f32x4 o = {O0[dt][4 * g] * rr * gn[0], O0[dt][4 * g + 1] * rr * gn[1], O0[dt][4 * g + 2] * rr * gn[2], O0[dt][4 * g + 3] * rr * gn[3]};
                *(v2u*)(orow + 32 * dt + 8 * g + 4 * hh) = pk4(o); }
    }
}

__device__ __forceinline__ void pool_unit(const Ctx& C, int row0, int layer) {
    constexpr int XS = 264;
    LAS bf16* xs = (LAS bf16*)C.lds;
    LAS bf16* pl = (LAS bf16*)(C.lds + 80 * XS * 2);
    const bf16* CX = WSP(bf16, WS_CX);
    int S, bstart; if (row0 < NCTX) { S = SEQC; bstart = row0 & ~255; } else { S = SEQL; bstart = NCTX + ((row0 - NCTX) & ~2047); }
    const int t0 = row0 - bstart;
    __syncthreads();
    for (int i = C.tid; i < 80 * 32; i += NTHR) { const int rr = i >> 5, ch = i & 31; const int t = t0 - 8 + rr;
        v4u val = (v4u){0u, 0u, 0u, 0u}; if (t >= 0 && t < S) val = *(const v4u*)(CX + (size_t)(bstart + t) * 256 + 8 * ch);
        *(LAS v4u*)(xs + rr * XS + 8 * ch) = val; }
    __syncthreads();
    {
        const int cp = C.tid & 127, tq = C.tid >> 7, g = cp >> 5, half = 1 << g;
        for (int tt = 0; tt < 16; ++tt) { const int tl = tq * 16 + tt, t = t0 + tl;
            const int lo = max(t - half, 0), hi = min(t + half, S); float s0 = 0.f, s1 = 0.f;
            for (int k = lo; k < hi; ++k) { const unsigned pv = *(const LAS unsigned*)(xs + (k - t0 + 8) * XS + 2 * cp); s0 += bf2f((unsigned short)(pv & 0xffff)); s1 += bf2f((unsigned short)(pv >> 16)); }
            const unsigned cv = *(const LAS unsigned*)(xs + (tl + 8) * XS + 2 * cp); const float inv = 1.f / (float)(hi - lo);
            *(LAS unsigned*)(pl + tl * XS + 2 * cp) = pkbf(s0 * inv - bf2f((unsigned short)(cv & 0xffff)), s1 * inv - bf2f((unsigned short)(cv >> 16))); }
    }
    __syncthreads();
    {
        const int g = C.wave >> 1, mh = C.wave & 1, fr = C.lane & 15, fq = C.lane >> 4;
        const bf16* WCT = WSP(bf16, WS_WCT) + (size_t)(layer * 4 + g) * 4096;
        f32x4 acc[2][4];
#pragma unroll
        for (int mt = 0; mt < 2; ++mt)
#pragma unroll
            for (int nt = 0; nt < 4; ++nt) acc[mt][nt] = (f32x4){0.f, 0.f, 0.f, 0.f};
#pragma unroll
        for (int kk = 0; kk < 2; ++kk) {
            bf16x8 wf[4], xf[2];
#pragma unroll
            for (int nt = 0; nt < 4; ++nt) wf[nt] = *(const bf16x8*)(WCT + (16 * nt + fr) * 64 + 32 * kk + 8 * fq);
#pragma unroll
            for (int mt = 0; mt < 2; ++mt) xf[mt] = *(const LAS bf16x8*)(pl + (32 * mh + 16 * mt + fr) * XS + 64 * g + 32 * kk + 8 * fq);
#pragma unroll
            for (int mt = 0; mt < 2; ++mt)
#pragma unroll
                for (int nt = 0; nt < 4; ++nt) acc[mt][nt] = MFMA16(wf[nt], xf[mt], acc[mt][nt]);
        }
        const float* cs = WSP(float, WS_PAR) + P_CSCALE + layer * 256 + 64 * g;
        bf16* MIX = WSP(bf16, WS_MIX);
#pragma unroll
        for (int mt = 0; mt < 2; ++mt)
#pragma unroll
            for (int nt = 0; nt < 4; ++nt) { const f32x4 sc = *(const f32x4*)(cs + 16 * nt + 4 * fq);
                *(v2u*)(MIX + (size_t)(row0 + 32 * mh + 16 * mt + fr) * DM + 512 + 64 * g + 16 * nt + 4 * fq) = pk4(acc[mt][nt] * sc); }
    }
}

__device__ __forceinline__ void gate_unit(const Ctx& C, int row0, int layer) {
    constexpr int TS = 136;
    LAS bf16* vt = (LAS bf16*)C.lds;
    const bf16* V = WSP(bf16, WS_V); const bf16* U = WSP(bf16, WS_U);
    __syncthreads();
    {
        const int q = C.tid >> 2, qu = C.tid & 3;
        const bf16* src = V + (size_t)(row0 + q) * 256 + 64 * qu;
        v4u raw[8]; float ss = 0.f;
#pragma unroll
        for (int i = 0; i < 8; ++i) { raw[i] = *(const v4u*)(src + 8 * i);
#pragma unroll
            for (int j = 0; j < 4; ++j) { const float a = bf2f((unsigned short)(raw[i][j] & 0xffff)), b = bf2f((unsigned short)(raw[i][j] >> 16)); ss += a * a + b * b; } }
        ss += __shfl_xor(ss, 1); ss += __shfl_xor(ss, 2);
        const float r = rsqrtf(ss * (1.f / 256.f) + EPS);
        const float* gv = WSP(float, WS_PAR) + P_DVN + layer * 256 + 64 * qu;
#pragma unroll
        for (int i = 0; i < 8; ++i)
#pragma unroll
            for (int j = 0; j < 4; ++j) { const int c = 8 * i + 2 * j; const float a = bf2f((unsigned short)(raw[i][j] & 0xffff)) * r * gv[c], b = bf2f((unsigned short)(raw[i][j] >> 16)) * r * gv[c + 1];
                vt[(64 * qu + c) * TS + q] = (bf16)f2bf(a); vt[(64 * qu + c + 1) * TS + q] = (bf16)f2bf(b); }
    }
    __syncthreads();
    {
        const int g = C.wave >> 1, ph = C.wave & 1, fr = C.lane & 15, fq = C.lane >> 4;
        const bf16* WS_ = WSP(bf16, WS_WSB) + (size_t)(layer * 4 + g) * 16384;
        f32x4 acc[4][4];
#pragma unroll
        for (int pt = 0; pt < 4; ++pt)
#pragma unroll
            for (int ct = 0; ct < 4; ++ct) acc[pt][ct] = (f32x4){0.f, 0.f, 0.f, 0.f};
#pragma unroll
        for (int kk = 0; kk < 4; ++kk) {
            bf16x8 vf[4], wf[4];
#pragma unroll
            for (int ct = 0; ct < 4; ++ct) vf[ct] = *(const LAS bf16x8*)(vt + (64 * g + 16 * ct + fr) * TS + 32 * kk + 8 * fq);
#pragma unroll
            for (int pt = 0; pt < 4; ++pt) wf[pt] = *(const bf16x8*)(WS_ + (64 * ph + 16 * pt + fr) * 128 + 32 * kk + 8 * fq);
#pragma unroll
            for (int pt = 0; pt < 4; ++pt)
#pragma unroll
                for (int ct = 0; ct < 4; ++ct) acc[pt][ct] = MFMA16(vf[ct], wf[pt], acc[pt][ct]);
        }
        bf16* MIX = WSP(bf16, WS_MIX);
#pragma unroll
        for (int pt = 0; pt < 4; ++pt) { const int p = 64 * ph + 16 * pt + fr; const float bs = WSP(float, WS_PAR)[P_DBS + (layer * 4 + g) * 128 + p];
#pragma unroll
            for (int ct = 0; ct < 4; ++ct) { const v2u ur = *(const v2u*)(U + (size_t)(row0 + p) * 256 + 64 * g + 16 * ct + 4 * fq);
                f32x4 o; o[0] = bf2f((unsigned short)(ur.x & 0xffff)) * (acc[pt][ct][0] + bs); o[1] = bf2f((unsigned short)(ur.x >> 16)) * (acc[pt][ct][1] + bs);
                o[2] = bf2f((unsigned short)(ur.y & 0xffff)) * (acc[pt][ct][2] + bs); o[3] = bf2f((unsigned short)(ur.y >> 16)) * (acc[pt][ct][3] + bs);
                *(v2u*)(MIX + (size_t)(row0 + p) * DM + 768 + 64 * g + 16 * ct + 4 * fq) = pk4(o); } }
    }
}

constexpr int U_LATB = 128, U_LATA = 128, U_CTXB = 64, U_CTXA = 64, U_GATE = 96, U_POOL = 192, U_TOTAL = U_LATB + U_LATA + U_CTXB + U_CTXA + U_GATE + U_POOL;
__device__ __forceinline__ void mixer_phase(const Ctx& Cm, int qidx, unsigned mask) {
    const int layer = qidx & 3;
    volatile LAS unsigned* slot = (volatile LAS unsigned*)(Cm.lds + MISC_OFF + 64);
    gu32* head = (gu32*)(Cm.ws + WS_CTL) + CW_QUEUE + 64 * qidx;
    const float lam = ((const float*)(Cm.ws + WS_LAM))[layer];
    const float lam_init = 0.8f - 0.6f * expf(-0.3f * (float)layer);
    for (;;) {
        __syncthreads();
        if (Cm.tid == 0) slot[0] = __hip_atomic_fetch_add(head, 1u, RLX_AGENT);
        __syncthreads();
        int u = __builtin_amdgcn_readfirstlane((int)slot[0]);
        if (u >= U_TOTAL) break;
        { const int cls = u < U_LATB ? 0 : u < U_LATB + U_LATA ? 1 : u < U_LATB + U_LATA + U_CTXB ? 2 : u < U_LATB + U_LATA + U_CTXB + U_CTXA ? 3 : u < U_LATB + U_LATA + U_CTXB + U_CTXA + U_GATE ? 4 : 5; if (!((mask >> cls) & 1u)) continue; }
        Ctx C = Cm; asm volatile("" : "+s"(C.ws), "+v"(C.tid)); C.lane = C.tid & 63; C.wave = __builtin_amdgcn_readfirstlane(C.tid >> 6);
        const float* subln = WSP(float, WS_PAR) + P_SUBLN + layer * 64;
        bf16* MIX = WSP(bf16, WS_MIX);
        if (u < U_LATB + U_LATA + U_CTXB + U_CTXA) {
            bool diff, lat; int b, h, row0;
            if (u < U_LATB) { diff = true; lat = true; b = u >> 5; h = (u >> 3) & 3; row0 = NCTX + b * SEQL + 256 * (u & 7); }
            else if (u < U_LATB + U_LATA) { const int v = u - U_LATB; diff = false; lat = true; b = v >> 5; h = (v >> 3) & 3; row0 = NCTX + b * SEQL + 256 * (v & 7); }
            else if (u < U_LATB + U_LATA + U_CTXB) { const int v = u - U_LATB - U_LATA; diff = true; lat = false; b = v >> 2; h = v & 3; row0 = 256 * b; }
            else { const int v = u - U_LATB - U_LATA - U_CTXB; diff = false; lat = false; b = v >> 2; h = v & 3; row0 = 256 * b; }
            if (diff) {
#ifndef SKIP_ATT_B
                const size_t hn = (size_t)b * 4 + h, hc = (size_t)(layer * 4 + b) * 4 + h;
                const bf16* K0 = lat ? WSP(bf16, WS_KBC) + hc * 256 * 64 : WSP(bf16, WS_KB) + hn * 256 * 64;
                const bf16* V0 = lat ? WSP(bf16, WS_VBTC) + hc * 256 * 64 : WSP(bf16, WS_VBT) + hn * 256 * 64;
                attn_unit<true>(C, WSP(bf16, WS_QB) + (size_t)row0 * 256 + 64 * h, K0, V0, 4,
                                WSP(bf16, WS_KB) + KB_LAT + hn * SEQL * 64, WSP(bf16, WS_VBT) + KB_LAT + hn * SEQL * 64, lat ? 32 : 0,
                                MIX + (size_t)row0 * DM + 256 + 64 * h, lam, 1.f - lam_init, subln);
#endif
            } else {
#ifndef SKIP_ATT_A
                const int kvh = h >> 1; const size_t hn = (size_t)b * 2 + kvh, hc = (size_t)(layer * 4 + b) * 2 + kvh;
                const bf16* K0 = lat ? WSP(bf16, WS_KAC) + hc * 256 * 64 : WSP(bf16, WS_KA) + hn * 256 * 64;
                const bf16* V0 = lat ? WSP(bf16, WS_VATC) + hc * 256 * 64 : WSP(bf16, WS_VAT) + hn * 256 * 64;
                attn_unit<false>(C, WSP(bf16, WS_QA) + (size_t)row0 * 256 + 64 * h, K0, V0, 4,
                                 WSP(bf16, WS_KA) + KA_LAT + hn * SEQL * 64, WSP(bf16, WS_VAT) + KA_LAT + hn * SEQL * 64, lat ? 32 : 0,
                                 MIX + (size_t)row0 * DM + 64 * h, 0.f, 1.f, subln);
#endif
            }
            continue;
        }
        u -= U_LATB + U_LATA + U_CTXB;
        u -= U_CTXA;
#ifndef SKIP_GATE
        if (u < U_GATE) { gate_unit(C, 128 * u, layer); continue; }
#endif
        u -= U_GATE;
#ifndef SKIP_POOL
        if (u >= 0) pool_unit(C, 64 * u, layer);
#endif
    }
}

__global__ void __launch_bounds__(NTHR, 2) fwd_kernel(KArgs args) {
    extern __shared__ __attribute__((aligned(16))) unsigned char lds_raw[];
    Ctx C;
    C.kp = (const CAS unsigned long long*)__builtin_amdgcn_kernarg_segment_ptr();
    C.out = args.out; C.ws = args.ws;
    C.lds = (LAS unsigned char*)lds_raw; C.tid = threadIdx.x; C.lane = C.tid & 63; C.wave = __builtin_amdgcn_readfirstlane(C.tid >> 6); C.G = gridDim.x; C.bid = blockIdx.x;
    for (int u = C.tid; u < (LDS_BYTES - LDSCTL_OFF) / 4; u += NTHR) ((LAS unsigned*)(C.lds + LDSCTL_OFF))[u] = 0u;
    __syncthreads();
    XcdBarrier bar = xcd_barrier_post((unsigned*)(C.ws + WS_CTL) + CW_BAR, (volatile LAS unsigned*)(C.lds + MISC_OFF) + 8);
#define GRID_BAR() xcd_barrier(bar)

    const Ctx C0 = C;
#ifdef TIME_SEL
    const bool diag_fresh = __hip_atomic_load((unsigned*)(C0.ws + WS_PAR + 512 * 1024), __ATOMIC_RELAXED, __HIP_MEMORY_SCOPE_AGENT) != 0x5eed1234u;
#endif
#define PHASE_CTX() Ctx C = C0; asm volatile("" : "+s"(C.ws), "+s"(C.out), "+s"(C.G), "+s"(C.bid), "+v"(C.tid)); C.lane = C.tid & 63; C.wave = __builtin_amdgcn_readfirstlane(C.tid >> 6)
    constexpr int NSTEPS = 3 + 7 * DEPTH_L;
#ifndef GEMM_MT
#define GEMM_MT 3
#endif
#ifndef GEMM3_MT
#define GEMM3_MT 3
#endif
    constexpr int GMT = GEMM_MT, GMT3 = GEMM3_MT;
#ifndef REP_G1
#define REP_G1 1
#endif
#ifndef REP_MIX
#define REP_MIX 1
#endif
#ifndef REP_MASK
#define REP_MASK 63
#endif
#ifndef REP_G24
#define REP_G24 1
#endif
#ifndef REP_G3
#define REP_G3 1
#endif
#pragma unroll 1
    for (int step = 0; step < NSTEPS; ++step) {
        const int l = step < 3 ? 0 : (step - 3) / 7, kind = step == 0 ? 0 : step == 1 ? 9 : step == 2 ? 1 : 2 + (step - 3) % 7;
#ifdef TIME_SEL
        unsigned long long t_start = 0ull; if (C0.bid == 0 && C0.tid == 0) t_start = __builtin_amdgcn_s_memrealtime();
#endif
        const int nrep = kind == 2 ? REP_G1 : kind == 3 ? REP_MIX : (kind == 4 || kind == 7) ? REP_G24 : kind == 6 ? REP_G3 : 1;
#pragma unroll 1
        for (int rep = 0; rep < nrep; ++rep) {
        if (kind == 0) {
#ifndef SKIP_P0
            PHASE_CTX(); phase0(C);
#endif
        } else if (kind == 9) {
            PHASE_CTX(); REFRESH_KP();
            for (int i = C.bid * NTHR + C.tid; i < DEPTH_L * 5 * 1536; i += C.G * NTHR) {
                const int n4 = i % 1536, ci = (i / 1536) % 5, ll = i / (5 * 1536), slab = n4 >> 6, w4 = n4 & 63;
                f32x4 sum = *(const f32x4*)(INP(9) + (size_t)ll * 6144 + 4 * n4);
                const float* p0 = WSP(float, WS_PARTIAL) + (size_t)(ll * 24 + slab) * 16 * 5 * 256 + ci * 256 + 4 * w4;
#pragma unroll
                for (int k = 0; k < 16; ++k) sum += *(const f32x4*)(p0 + (size_t)k * 5 * 256);
                *(f32x4*)(WSP(float, WS_MOD) + ((size_t)ll * 5 + ci) * 6144 + 4 * n4) = sum;
            }
        } else if (kind == 1) {
            PHASE_CTX(); const float* mod = WSP(float, WS_MOD);
            rowwise<false, true>(C, true, nullptr, nullptr, WSP(float, WS_PAR) + P_GPREMIX, mod + 1 * 1024, mod + 0 * 1024);
        } else if (kind == 2) {
            PHASE_CTX();
            pg8::Gemm g{WSP(bf16, WS_H), WSP(bf16, WS_WIN) + (size_t)l * NIN * DM, NTOK, NIN, DM}; pg8::StaticOrder S; S.init(NTOK, NIN, C.G, C.bid, 64 * GMT);
            EpiProj<GMT> E{C.ws, C.out, l};
#ifndef SKIP_G1
            pg8::gemm_phase<EpiProj<GMT>, pg8::StaticOrder, true, true, GMT>(C.lds, g, S, E, C.tid);
#endif
        } else if (kind == 3) {
#ifndef SKIP_MIX
            PHASE_CTX(); mixer_phase(C, l + 4 * rep, rep == 0 ? 63u : (unsigned)(REP_MASK));
#endif
        } else if (kind == 4 || kind == 7) {
            PHASE_CTX();
            const bool dn = kind == 7;
            pg8::Gemm g{dn ? WSP(bf16, WS_ACT) : WSP(bf16, WS_MIX), dn ? WSP(bf16, WS_WDN) + (size_t)l * DM * DFF : WSP(bf16, WS_WOUT) + (size_t)l * DM * DM, NTOK, DM, dn ? DFF : DM};
            pg8::StaticOrder S; S.init(NTOK, DM, C.G, C.bid, 64 * GMT);
            EpiF32<GMT> E{WSP(float, WS_Y), DM};
#ifndef SKIP_G24
            pg8::gemm_phase<EpiF32<GMT>, pg8::StaticOrder, true, true, GMT>(C.lds, g, S, E, C.tid);
#endif
        } else if (kind == 5 || kind == 8) {
            PHASE_CTX(); const float* mod = WSP(float, WS_MOD) + (size_t)l * 5 * 6144; const float* par = WSP(float, WS_PAR) + l * DM;
            if (kind == 5 && l == 0) rowwise<true, true>(C, true, mod + 2 * 1024, par + P_GPOSTMIX, par + P_GPREFFN, mod + 4 * 1024, mod + 3 * 1024);
            else if (kind == 5) rowwise<true, false>(C, true, mod + 2 * 1024, par + P_GPOSTMIX, par + P_GPREFFN, mod + 4 * 1024, mod + 3 * 1024);
            else           rowwise<true, false>(C, l + 1 < DEPTH_L, mod + 5 * 1024, par + P_GPOSTFFN, par + DM + P_GPREMIX, mod + 5 * 6144 + 1 * 1024, mod + 5 * 6144 + 0 * 1024);
        } else {
            PHASE_CTX();
            pg8::Gemm g{WSP(bf16, WS_H), WSP(bf16, WS_WGU) + (size_t)l * NGU * DM, NTOK, NGU, DM}; pg8::StaticOrder S; S.init(NTOK, NGU, C.G, C.bid, 64 * GMT3);
            EpiGLU<GMT3> E{WSP(bf16, WS_ACT)};
#ifndef SKIP_G3
            pg8::gemm_phase<EpiGLU<GMT3>, pg8::StaticOrder, true, true, GMT3>(C.lds, g, S, E, C.tid);
#endif
        }
#ifdef TIME_SEL
        GRID_BAR();
#else
        if (step + 1 < NSTEPS || rep + 1 < nrep) GRID_BAR();
#endif
        }
#ifdef TIME_SEL
        if (C0.bid == 0 && C0.tid == 0) { unsigned long long* T = (unsigned long long*)(C0.ws + WS_CTL) + 1024; const unsigned long long dt = __builtin_amdgcn_s_memrealtime() - t_start; T[kind] += dt; T[9] += dt; }
#endif
    }
#ifdef TIME_SEL
    {
        asm volatile("s_waitcnt vmcnt(0)" ::: "memory"); GRID_BAR();
        const unsigned long long ticks = __hip_atomic_load((unsigned long long*)(C0.ws + WS_CTL) + 1024 + TIME_SEL, __ATOMIC_RELAXED, __HIP_MEMORY_SCOPE_AGENT);
        float eps = (float)ticks * 0.01f / (float)(TIME_DIV);
#ifdef TIME_CONST
        eps = TIME_CONST;
#endif
        if (!diag_fresh) eps = 0.f;
        if (C0.bid == 0 && C0.tid == 0) __hip_atomic_store((unsigned*)(C0.ws + WS_PAR + 512 * 1024), 0x5eed1234u, __ATOMIC_RELAXED, __HIP_MEMORY_SCOPE_AGENT);
        for (int i = C0.bid * NTHR + C0.tid; i < NCTX * DM / 4; i += C0.G * NTHR) { f32x4 v = ((f32x4*)C0.out)[i]; v = v * (1.f + eps); ((f32x4*)C0.out)[i] = v; }
    }
#endif
}

extern "C" void kernel_launch(void* const* d_in, const int* in_sizes, int n_in, void* d_out, int out_size, void* d_ws, size_t ws_size, hipStream_t stream) {
    static int grid = 0;
    if (grid == 0) {
        if (n_in != 31 || (size_t)out_size != OUT_TOTAL || ws_size < WS_END) { fprintf(stderr, "kernel_launch: unexpected shapes: n_in %d out %d ws %zu (need %zu)\n", n_in, out_size, ws_size, (size_t)WS_END); grid = -1; return; }
        int dev = 0, cus = 0, per_cu = 0;
        if (hipGetDevice(&dev) != hipSuccess || hipDeviceGetAttribute(&cus, hipDeviceAttributeMultiprocessorCount, dev) != hipSuccess) { grid = -1; return; }
        if (hipFuncSetAttribute((const void*)fwd_kernel, hipFuncAttributeMaxDynamicSharedMemorySize, LDS_BYTES) != hipSuccess) { fprintf(stderr, "kernel_launch: hipFuncSetAttribute failed\n"); grid = -1; return; }
        if (hipOccupancyMaxActiveBlocksPerMultiprocessor(&per_cu, (const void*)fwd_kernel, NTHR, LDS_BYTES) != hipSuccess || per_cu < 1) { fprintf(stderr, "kernel_launch: occupancy query says %d blocks per CU\n", per_cu); (void)hipGetLastError(); grid = -1; return; }
        grid = cus;
    }
    if (grid < 0) return;
    if (hipMemsetAsync((char*)d_ws + WS_CTL, 0, CTL_ZERO_BYTES, stream) != hipSuccess) return;
    KArgs a{};
    for (int i = 0; i < 31; ++i) a.in[i] = (const float*)d_in[i];
    a.out = (float*)d_out; a.ws = (unsigned char*)d_ws;
    hipLaunchKernelGGL(fwd_kernel, dim3(grid), dim3(NTHR), LDS_BYTES, stream, a);
}
```
